# Optimizing an MI355X kernel written in HIP

```python
import math
import jax, jax.numpy as jnp
from jax import lax
import numpy as np

D_MODEL = 4096
BATCH = 8
SEQ = 2048
DEPTH = 2

MIX_WIDTH = D_MODEL
S5_WIDTH = MIX_WIDTH // 2
S5_GROUP = 16
S5_GROUPS = S5_WIDTH // S5_GROUP
S5_STATE = 64
S5_DT_MIN = 1e-3
S5_DT_MAX = 1e-1
GLA_WIDTH = MIX_WIDTH - S5_WIDTH
GLA_HEADS = 8
GLA_DV = GLA_WIDTH // GLA_HEADS
GLA_DK = GLA_DV // 2
GLA_KEY_WIDTH = GLA_HEADS * GLA_DK
GLA_GATE_RANK = 16
GLA_TAU = 16.0
HG_EXPAND = 128
HG_HEADS = MIX_WIDTH // HG_EXPAND
HG_DK = HG_EXPAND
HG_DV = MIX_WIDTH // HG_HEADS
HG_KEY_WIDTH = HG_HEADS * HG_DK
HG_VAL_WIDTH = HG_HEADS * HG_DV
CHUNK = 64
FFN_HIDDEN = -(-8 * D_MODEL // (3 * 256)) * 256
N_EVEN = (DEPTH + 1) // 2
N_ODD = DEPTH // 2
DEEPNORM_ALPHA = (2.0 * DEPTH) ** 0.25
DEEPNORM_BETA = (8.0 * DEPTH) ** -0.25
NORM_EPS = 1e-5
EVEN_SPLITS = (S5_WIDTH,
               S5_WIDTH + GLA_KEY_WIDTH,
               S5_WIDTH + 2 * GLA_KEY_WIDTH,
               S5_WIDTH + 2 * GLA_KEY_WIDTH + GLA_WIDTH,
               S5_WIDTH + 2 * GLA_KEY_WIDTH + 2 * GLA_WIDTH)
EVEN_IN = S5_WIDTH + 2 * GLA_KEY_WIDTH + 2 * GLA_WIDTH + GLA_GATE_RANK
ODD_SPLITS = (HG_KEY_WIDTH, 2 * HG_KEY_WIDTH, 2 * HG_KEY_WIDTH + HG_VAL_WIDTH)
ODD_IN = 2 * HG_KEY_WIDTH + HG_VAL_WIDTH + MIX_WIDTH

kernel_name = "hybrid_s5_gla_hgrn2_deepnorm"


def layer_norm(x, g, b):
    x32 = x.astype(jnp.float32)
    mu = jnp.mean(x32, axis=-1, keepdims=True)
    var = jnp.mean(jnp.square(x32 - mu), axis=-1, keepdims=True)
    return ((x32 - mu) * lax.rsqrt(var + NORM_EPS) * g + b).astype(x.dtype)


def gated_head_rmsnorm(o, gain, gate):
    o32 = o.astype(jnp.float32)
    o32 = o32 * lax.rsqrt(jnp.mean(jnp.square(o32), axis=-1, keepdims=True) + NORM_EPS) * gain
    return o32.reshape(gate.shape) * jax.nn.silu(gate.astype(jnp.float32))


def chunked_gated_linear_recurrence(q, k, v, log_a):
    bsz, t, h, dk = q.shape
    dv = v.shape[-1]
    n = t // CHUNK
    to_chunks = lambda a: a.astype(jnp.float32).reshape(bsz, n, CHUNK, h, a.shape[-1])
    q, k, v, log_a = to_chunks(q), to_chunks(k), to_chunks(v), to_chunks(log_a)
    b = jnp.cumsum(log_a, axis=2)
    b_end = b[:, :, -1:]
    q_dec = q * jnp.exp(b)
    k_inv = k * jnp.exp(-b)
    causal = jnp.tril(jnp.ones((CHUNK, CHUNK), dtype=bool))
    scores = jnp.einsum('bnlhd,bnmhd->bnhlm', q_dec, k_inv)
    scores = jnp.where(causal, scores, 0.0)
    o_intra = jnp.einsum('bnhlm,bnmhv->bnlhv', scores, v)
    k_end = k * jnp.exp(b_end - b)
    chunk_kv = jnp.einsum('bnlhd,bnlhv->bnhdv', k_end, v)
    chunk_decay = jnp.exp(b_end[:, :, 0])

    def step(state, inp):
        dec, kv = inp
        return dec[..., None] * state + kv, state

    s0 = jnp.zeros((bsz, h, dk, dv), jnp.float32)
    _, s_prev = lax.scan(step, s0, (jnp.moveaxis(chunk_decay, 1, 0), jnp.moveaxis(chunk_kv, 1, 0)))
    s_prev = jnp.moveaxis(s_prev, 0, 1)
    o_inter = jnp.einsum('bnlhd,bnhdv->bnlhv', q_dec, s_prev)
    return (o_intra + o_inter).reshape(bsz, t, h, dv)


def _complex_affine_combine(e1, e2):
    a1r, a1i, b1r, b1i = e1
    a2r, a2i, b2r, b2i = e2
    return (a2r * a1r - a2i * a1i,
            a2r * a1i + a2i * a1r,
            a2r * b1r - a2i * b1i + b2r,
            a2r * b1i + a2i * b1r + b2i)


def s5_mixer(u, lam_re, lam_im, log_dt, b_re, b_im, c_re, c_im, d_skip, w_glu):
    bsz, t, _ = u.shape
    uf = u.astype(jnp.float32)
    ug = uf.reshape(bsz, t, S5_GROUPS, S5_GROUP)
    dt = jnp.exp(log_dt.astype(jnp.float32))[:, None]
    lr, li = lam_re.astype(jnp.float32), lam_im.astype(jnp.float32)
    mag = jnp.exp(lr * dt)
    abar_re, abar_im = mag * jnp.cos(li * dt), mag * jnp.sin(li * dt)
    nr, ni = abar_re - 1.0, abar_im
    den = lr * lr + li * li
    fr, fi = (nr * lr + ni * li) / den, (ni * lr - nr * li) / den
    br, bi = b_re.astype(jnp.float32), b_im.astype(jnp.float32)
    bb_re = fr[..., None] * br - fi[..., None] * bi
    bb_im = fr[..., None] * bi + fi[..., None] * br
    bu_re = jnp.einsum('btgi,gpi->btgp', ug, bb_re)
    bu_im = jnp.einsum('btgi,gpi->btgp', ug, bb_im)
    a_re = jnp.broadcast_to(abar_re, (1, t, S5_GROUPS, S5_STATE))
    a_im = jnp.broadcast_to(abar_im, (1, t, S5_GROUPS, S5_STATE))
    _, _, s_re, s_im = lax.associative_scan(_complex_affine_combine, (a_re, a_im, bu_re, bu_im), axis=1)
    y = (jnp.einsum('btgp,gip->btgi', s_re, c_re.astype(jnp.float32))
         - jnp.einsum('btgp,gip->btgi', s_im, c_im.astype(jnp.float32)))
    y = y.reshape(bsz, t, S5_WIDTH) + d_skip.astype(jnp.float32) * uf
    y = jax.nn.gelu(y)
    y = y * jax.nn.sigmoid(y @ w_glu.astype(jnp.float32))
    return y.astype(u.dtype)


def even_mixer(x, w_in, w_out, lam_re, lam_im, log_dt, b_re, b_im, c_re, c_im, d_skip, w_glu,
               w_alpha, b_alpha, norm_g):
    bsz, t, _ = x.shape
    h = x @ w_in
    u, q, k, v, g, a_lr = jnp.split(h, EVEN_SPLITS, axis=-1)
    y_s5 = s5_mixer(u, lam_re, lam_im, log_dt, b_re, b_im, c_re, c_im, d_skip, w_glu)
    q = q.reshape(bsz, t, GLA_HEADS, GLA_DK) * (GLA_DK ** -0.5)
    k = k.reshape(bsz, t, GLA_HEADS, GLA_DK)
    v = v.reshape(bsz, t, GLA_HEADS, GLA_DV)
    log_a = jax.nn.log_sigmoid((a_lr @ w_alpha + b_alpha).astype(jnp.float32)) / GLA_TAU
    o = chunked_gated_linear_recurrence(q, k, v, log_a.reshape(bsz, t, GLA_HEADS, GLA_DK))
    y_gla = gated_head_rmsnorm(o, norm_g, g).astype(x.dtype)
    y = jnp.concatenate([y_s5, y_gla], axis=-1)
    return y @ w_out


def odd_mixer(x, w_in, w_out, lower_bound, norm_g):
    bsz, t, _ = x.shape
    h = x @ w_in
    q, f_logit, i, g = jnp.split(h, ODD_SPLITS, axis=-1)
    lb = lower_bound.astype(jnp.float32)
    f = lb + (1.0 - lb) * jax.nn.sigmoid(f_logit.astype(jnp.float32))
    k = 1.0 - f
    i = jax.nn.silu(i.astype(jnp.float32))
    o = chunked_gated_linear_recurrence(
        q.reshape(bsz, t, HG_HEADS, HG_DK),
        k.reshape(bsz, t, HG_HEADS, HG_DK),
        i.reshape(bsz, t, HG_HEADS, HG_DV),
        jnp.log(f).reshape(bsz, t, HG_HEADS, HG_DK))
    y = gated_head_rmsnorm(o, norm_g, g).astype(x.dtype)
    return y @ w_out


def swiglu_ffn(x, w_gate, w_up, w_down):
    return (jax.nn.silu(x @ w_gate) * (x @ w_up)) @ w_down


def setup_inputs(seed: int = 0) -> dict:
    key = jax.random.key(seed)
    ks = jax.random.split(key, 26)
    f32 = jnp.float32
    nrm = lambda k, shape, std: std * jax.random.normal(k, shape, f32)
    n_idx = jnp.arange(S5_STATE, dtype=f32)
    return {
        "x": nrm(ks[0], (BATCH, SEQ, D_MODEL), 1.0),
        "ev_w_in": nrm(ks[1], (N_EVEN, D_MODEL, EVEN_IN), D_MODEL ** -0.5),
        "ev_w_out": nrm(ks[2], (N_EVEN, MIX_WIDTH, D_MODEL), DEEPNORM_BETA * MIX_WIDTH ** -0.5),
        "s5_lam_re": -0.5 + nrm(ks[3], (N_EVEN, S5_GROUPS, S5_STATE), 0.01),
        "s5_lam_im": math.pi * n_idx + nrm(ks[4], (N_EVEN, S5_GROUPS, S5_STATE), 0.01),
        "s5_log_dt": jax.random.uniform(ks[5], (N_EVEN, S5_GROUPS), f32,
                                        math.log(S5_DT_MIN), math.log(S5_DT_MAX)),
        "s5_b_re": nrm(ks[6], (N_EVEN, S5_GROUPS, S5_STATE, S5_GROUP), (2 * S5_GROUP) ** -0.5),
        "s5_b_im": nrm(ks[7], (N_EVEN, S5_GROUPS, S5_STATE, S5_GROUP), (2 * S5_GROUP) ** -0.5),
        "s5_c_re": nrm(ks[8], (N_EVEN, S5_GROUPS, S5_GROUP, S5_STATE), S5_STATE ** -0.5),
        "s5_c_im": nrm(ks[9], (N_EVEN, S5_GROUPS, S5_GROUP, S5_STATE), S5_STATE ** -0.5),
        "s5_d": nrm(ks[10], (N_EVEN, S5_WIDTH), 1.0),
        "s5_w_glu": nrm(ks[11], (N_EVEN, S5_WIDTH, S5_WIDTH), S5_WIDTH ** -0.5),
        "gla_w_alpha": nrm(ks[12], (N_EVEN, GLA_GATE_RANK, GLA_KEY_WIDTH), GLA_GATE_RANK ** -0.5),
        "gla_b_alpha": nrm(ks[13], (N_EVEN, GLA_KEY_WIDTH), 0.1),
        "gla_norm_g": 1.0 + nrm(ks[14], (N_EVEN, GLA_DV), 0.01),
        "od_w_in": nrm(ks[15], (N_ODD, D_MODEL, ODD_IN), D_MODEL ** -0.5),
        "od_w_out": nrm(ks[16], (N_ODD, MIX_WIDTH, D_MODEL), DEEPNORM_BETA * MIX_WIDTH ** -0.5),
        "hg_lb_table": nrm(ks[17], (DEPTH, HG_KEY_WIDTH), 0.1),
        "hg_norm_g": 1.0 + nrm(ks[18], (N_ODD, HG_DV), 0.01),
        "ln_mix_g": 1.0 + nrm(ks[19], (DEPTH, D_MODEL), 0.01),
        "ln_mix_b": nrm(ks[20], (DEPTH, D_MODEL), 0.01),
        "ln_ffn_g": 1.0 + nrm(ks[21], (DEPTH, D_MODEL), 0.01),
        "ln_ffn_b": nrm(ks[22], (DEPTH, D_MODEL), 0.01),
        "ffn_w_gate": nrm(ks[23], (DEPTH, D_MODEL, FFN_HIDDEN), D_MODEL ** -0.5),
        "ffn_w_up": nrm(ks[24], (DEPTH, D_MODEL, FFN_HIDDEN), D_MODEL ** -0.5),
        "ffn_w_down": nrm(ks[25], (DEPTH, FFN_HIDDEN, D_MODEL), DEEPNORM_BETA * FFN_HIDDEN ** -0.5),
    }


def reference(x, ev_w_in, ev_w_out, s5_lam_re, s5_lam_im, s5_log_dt, s5_b_re, s5_b_im,
              s5_c_re, s5_c_im, s5_d, s5_w_glu, gla_w_alpha, gla_b_alpha, gla_norm_g,
              od_w_in, od_w_out, hg_lb_table, hg_norm_g, ln_mix_g, ln_mix_b, ln_ffn_g, ln_ffn_b,
              ffn_w_gate, ffn_w_up, ffn_w_down):
    lb_soft = jax.nn.softmax(hg_lb_table.astype(jnp.float32), axis=0)
    lower_bounds = jnp.cumsum(lb_soft, axis=0) - lb_soft[0]
    for layer in range(DEPTH):
        if layer % 2 == 0:
            e = layer // 2
            sub = even_mixer(x, ev_w_in[e], ev_w_out[e], s5_lam_re[e], s5_lam_im[e], s5_log_dt[e],
                             s5_b_re[e], s5_b_im[e], s5_c_re[e], s5_c_im[e], s5_d[e], s5_w_glu[e],
                             gla_w_alpha[e], gla_b_alpha[e], gla_norm_g[e])
        else:
            o = layer // 2
            sub = odd_mixer(x, od_w_in[o], od_w_out[o], lower_bounds[layer], hg_norm_g[o])
        x = layer_norm(DEEPNORM_ALPHA * x + sub, ln_mix_g[layer], ln_mix_b[layer])
        x = layer_norm(DEEPNORM_ALPHA * x + swiglu_ffn(x, ffn_w_gate[layer], ffn_w_up[layer], ffn_w_down[layer]),
                       ln_ffn_g[layer], ln_ffn_b[layer])
    return x
```

```cpp
#include <hip/hip_runtime.h>
#include <cstdio>
#include <cstdint>

#ifndef MK_N_LAUNCHES
#define MK_N_LAUNCHES 1
#endif

namespace pg8 {
#define PG8_LAS __attribute__((address_space(3)))
typedef unsigned short bf16_t;
typedef short bf16x8 __attribute__((ext_vector_type(8)));
typedef float f32x4 __attribute__((ext_vector_type(4)));
typedef unsigned u32x4 __attribute__((ext_vector_type(4)));
constexpr int BM = 256, BK = 64, HALF = 128, HTB = HALF * BK * 2, STAGE_BYTES = 8 * HTB, NXCD = 8, WGM = 8;

__host__ __device__ __forceinline__ int lds_byte(int r, int c) { const int st = (r >> 4) * 2 + (c >> 5), rr = r & 15, cc = c & 31, ob = rr * 64 + cc * 2; return st * 1024 + (ob ^ (((ob >> 9) & 1) << 5)); }
__host__ __device__ __forceinline__ void stage_rc(int b, int& R, int& C) { const int st = b / 1024, sb = b % 1024, swz = sb ^ (((sb >> 9) & 1) << 5); R = (st >> 1) * 16 + swz / 64; C = (st & 1) * 32 + (swz % 64) / 2; }
__host__ __device__ __forceinline__ int perm32(int rho) { const int n = rho >> 4, i = rho & 15; return 8 * (i >> 2) + 4 * n + (i & 3); }

struct Unit { int pm, pn; };
struct Gemm { const bf16_t* A; const bf16_t* Bt; int M, N, K; size_t bsA; };

struct StaticOrder {
    int nM, nN, nwg, G, c;
    __host__ __device__ void init(int M, int N, int G_, int c_) { nM = M / BM; nN = N / BM; nwg = nM * nN; G = G_; c = c_; }
    __host__ __device__ bool next(int i, Unit& u) const {
        const long L = (long)i * G + c; if (L >= nwg) return false;
        int wgid = (int)L; { const int q = nwg / NXCD, r = nwg % NXCD, xcd = wgid % NXCD, off = wgid / NXCD; wgid = (xcd < r ? xcd * (q + 1) : r * (q + 1) + (xcd - r) * q) + off; }
        const int nig = WGM * nN, gid = wgid / nig, fm = gid * WGM, gsz = (nM - fm) < WGM ? (nM - fm) : WGM;
        u.pm = fm + ((wgid % nig) % gsz); u.pn = (wgid % nig) / gsz; return true;
    }
    __device__ __forceinline__ void a_ready(const Unit&) const {}
    __device__ __forceinline__ void done(const Unit&) const {}
};

__device__ __forceinline__ unsigned cvt_pk_bf16(float lo, float hi) { unsigned r; asm volatile("v_cvt_pk_bf16_f32 %0, %1, %2" : "=v"(r) : "v"(lo), "v"(hi)); return r; }
__device__ __forceinline__ float bflo(unsigned x) { return __uint_as_float(x << 16); }
__device__ __forceinline__ float bfhi(unsigned x) { return __uint_as_float(x & 0xffff0000u); }
typedef _Float16 zh2 __attribute__((ext_vector_type(2)));
typedef float zf2 __attribute__((ext_vector_type(2)));
__device__ __forceinline__ unsigned pk_h2(float lo, float hi) { const zf2 f = {__builtin_fminf(__builtin_fmaxf(lo, -65504.f), 65504.f), __builtin_fminf(__builtin_fmaxf(hi, -65504.f), 65504.f)}; return __builtin_bit_cast(unsigned, __builtin_convertvector(f, zh2)); }
__device__ __forceinline__ float hflo(unsigned x) { return (float)__builtin_bit_cast(zh2, x).x; }
__device__ __forceinline__ float hfhi(unsigned x) { return (float)__builtin_bit_cast(zh2, x).y; }
__device__ __forceinline__ float sigmoidf_(float x) { return __builtin_amdgcn_rcpf(1.0f + __expf(-x)); }

struct EpiBf16 {
    static constexpr bool PERM = true, AFTER_DRAIN = false;
    bf16_t* O; int ldc;
    __device__ __forceinline__ void operator()(const f32x4 (&acc)[2][2][4][2], const Unit& u, int wr, int wc, int fr, int fq) const {
        const int row0 = u.pm * BM + wr * 64 + fr, col0 = u.pn * BM + wc * 32 + 8 * fq;
#pragma unroll
        for (int ai = 0; ai < 2; ++ai)
#pragma unroll
            for (int m = 0; m < 4; ++m) { bf16_t* rowp = O + (size_t)(row0 + ai * HALF + m * 16) * ldc + col0;
#pragma unroll
                for (int bj = 0; bj < 2; ++bj) { const f32x4 v0 = acc[ai][bj][m][0], v1 = acc[ai][bj][m][1];
                    u32x4 w; w.x = cvt_pk_bf16(v0[0], v0[1]); w.y = cvt_pk_bf16(v0[2], v0[3]); w.z = cvt_pk_bf16(v1[0], v1[1]); w.w = cvt_pk_bf16(v1[2], v1[3]);
                    *(u32x4*)(rowp + bj * HALF) = w; } }
    }
};
struct EpiGlu {
    static constexpr bool PERM = true, AFTER_DRAIN = false;
    const bf16_t* A; int lda; bf16_t* O; int ldc;
    __device__ __forceinline__ void operator()(const f32x4 (&acc)[2][2][4][2], const Unit& u, int wr, int wc, int fr, int fq) const {
        const int row0 = u.pm * BM + wr * 64 + fr, col0 = u.pn * BM + wc * 32 + 8 * fq;
#pragma unroll
        for (int ai = 0; ai < 2; ++ai) {
            u32x4 yv[4][2];
#pragma unroll
            for (int m = 0; m < 4; ++m)
#pragma unroll
                for (int bj = 0; bj < 2; ++bj) yv[m][bj] = *(const u32x4*)(A + (size_t)(row0 + ai * HALF + m * 16) * lda + col0 + bj * HALF);
#pragma unroll
            for (int m = 0; m < 4; ++m) { const size_t r = (size_t)(row0 + ai * HALF + m * 16);
#pragma unroll
                for (int bj = 0; bj < 2; ++bj) { const f32x4 v0 = acc[ai][bj][m][0], v1 = acc[ai][bj][m][1];
                    const u32x4 y = yv[m][bj];
                    u32x4 w;
                    w.x = cvt_pk_bf16(bflo(y.x) * sigmoidf_(v0[0]), bfhi(y.x) * sigmoidf_(v0[1]));
                    w.y = cvt_pk_bf16(bflo(y.y) * sigmoidf_(v0[2]), bfhi(y.y) * sigmoidf_(v0[3]));
                    w.z = cvt_pk_bf16(bflo(y.z) * sigmoidf_(v1[0]), bfhi(y.z) * sigmoidf_(v1[1]));
                    w.w = cvt_pk_bf16(bflo(y.w) * sigmoidf_(v1[2]), bfhi(y.w) * sigmoidf_(v1[3]));
                    *(u32x4*)(O + r * ldc + col0 + bj * HALF) = w; } }
            asm volatile("" ::: "memory"); }
    }
};
template <bool LNRES> struct EpiResT {
    static constexpr bool PERM = false, AFTER_DRAIN = false;
    const float* res; bf16_t* Z; int ldc; float alpha; const float* stats; const float* gam; const float* bet;
    __device__ __forceinline__ void operator()(const f32x4 (&acc)[2][2][4][2], const Unit& u, int wr, int wc, int fr, int fq) const {
        const int row0 = u.pm * BM + wr * 64 + fr, col0 = u.pn * BM + wc * 32 + 4 * fq;
        f32x4 gv[2][2], bv[2][2];
        if constexpr (LNRES) {
#pragma unroll
            for (int bj = 0; bj < 2; ++bj)
#pragma unroll
                for (int n = 0; n < 2; ++n) { gv[bj][n] = *(const f32x4*)(gam + col0 + bj * HALF + n * 16); bv[bj][n] = *(const f32x4*)(bet + col0 + bj * HALF + n * 16); }
        }
        if constexpr (LNRES) {
#pragma unroll
            for (int ai = 0; ai < 2; ++ai) {
                unsigned long long zr[4][2][2]; zf2 stv[4];
#pragma unroll
                for (int m = 0; m < 4; ++m) { const int row = row0 + ai * HALF + m * 16; const size_t off = (size_t)row * ldc + col0;
                    stv[m] = *(const zf2*)(stats + 2 * row);
#pragma unroll
                    for (int bj = 0; bj < 2; ++bj)
#pragma unroll
                        for (int n = 0; n < 2; ++n) zr[m][bj][n] = *(const unsigned long long*)(Z + off + bj * HALF + n * 16); }
                asm volatile("" ::: "memory");
#pragma unroll
                for (int m = 0; m < 4; ++m) { const size_t off = (size_t)(row0 + ai * HALF + m * 16) * ldc + col0; const float mu = stv[m].x, rsd = stv[m].y;
#pragma unroll
                    for (int bj = 0; bj < 2; ++bj)
#pragma unroll
                        for (int n = 0; n < 2; ++n) { const unsigned lo = (unsigned)zr[m][bj][n], hi = (unsigned)(zr[m][bj][n] >> 32);
                            f32x4 r = (f32x4){hflo(lo), hfhi(lo), hflo(hi), hfhi(hi)};
                            r = (r - mu) * rsd * gv[bj][n] + bv[bj][n];
                            const f32x4 zn = r * alpha + acc[ai][bj][m][n];
                            *(unsigned long long*)(Z + off + bj * HALF + n * 16) = ((unsigned long long)pk_h2(zn[2], zn[3]) << 32) | pk_h2(zn[0], zn[1]); } }
                asm volatile("" ::: "memory"); }
        } else {
#pragma unroll
        for (int ai = 0; ai < 2; ++ai)
#pragma unroll
            for (int mp = 0; mp < 4; mp += 2) {
                f32x4 rs[2][2][2];
#pragma unroll
                for (int mm = 0; mm < 2; ++mm) { const size_t off = (size_t)(row0 + ai * HALF + (mp + mm) * 16) * ldc + col0;
#pragma unroll
                    for (int bj = 0; bj < 2; ++bj)
#pragma unroll
                        for (int n = 0; n < 2; ++n) rs[mm][bj][n] = *(const f32x4*)(res + off + bj * HALF + n * 16); }
#pragma unroll
                for (int mm = 0; mm < 2; ++mm) { const size_t off = (size_t)(row0 + ai * HALF + (mp + mm) * 16) * ldc + col0;
#pragma unroll
                    for (int bj = 0; bj < 2; ++bj)
#pragma unroll
                        for (int n = 0; n < 2; ++n) { const f32x4 zn = rs[mm][bj][n] * alpha + acc[ai][bj][mp + mm][n];
                            *(unsigned long long*)(Z + off + bj * HALF + n * 16) = ((unsigned long long)pk_h2(zn[2], zn[3]) << 32) | pk_h2(zn[0], zn[1]); } }
                asm volatile("" ::: "memory"); }
        }
    }
};
struct EpiSwiGlu {
    static constexpr bool PERM = true, AFTER_DRAIN = false;
    bf16_t* O; int ldc; size_t bs;
    __device__ __forceinline__ void operator()(const f32x4 (&acc)[2][2][4][2], const Unit& u, int wr, int wc, int fr, int fq) const {
        const int row0 = u.pm * BM + wr * 64 + fr, col0 = u.pn * HALF + wc * 32 + 8 * fq;
        bf16_t* Ob = O + (size_t)(row0 >> 11) * bs + col0; const int lr0 = row0 & 2047;
#pragma unroll
        for (int ai = 0; ai < 2; ++ai)
#pragma unroll
            for (int m = 0; m < 4; ++m) { bf16_t* rowp = Ob + (size_t)(lr0 + ai * HALF + m * 16) * ldc;
                float o[8];
#pragma unroll
                for (int n = 0; n < 2; ++n)
#pragma unroll
                    for (int j = 0; j < 4; ++j) { const float g = acc[ai][0][m][n][j], up = acc[ai][1][m][n][j]; o[4 * n + j] = g * sigmoidf_(g) * up; }
                u32x4 w; w.x = cvt_pk_bf16(o[0], o[1]); w.y = cvt_pk_bf16(o[2], o[3]); w.z = cvt_pk_bf16(o[4], o[5]); w.w = cvt_pk_bf16(o[6], o[7]);
                *(u32x4*)rowp = w; }
    }
};

template <class Epi, class Sched, bool ALIGN_EPI = false, bool SP2 = false>
__device__ __forceinline__ void gemm_phase(PG8_LAS unsigned char* lds, const Gemm g, const Sched& S, const Epi& E) {
    const int tid = threadIdx.x, wid = __builtin_amdgcn_readfirstlane(tid >> 6), lane = tid & 63, wr = wid >> 2, wc = wid & 3, fr = lane & 15, fq = lane >> 4;
    const int K = g.K, nt = K / BK;
    unsigned voffA[2], voffB[2];
#pragma unroll
    for (int i = 0; i < 2; ++i) { int R, C; stage_rc(tid * 16 + i * 8192, R, C); const int Rb = Epi::PERM ? ((R & ~31) + perm32(R & 31)) : R;
        voffA[i] = (unsigned)(R * K + C) * 2u; voffB[i] = (unsigned)(Rb * K + C) * 2u; }
    const size_t kstep = (size_t)(BK * 2);
    const size_t hstep = (size_t)HALF * K * 2;
    const size_t tstep = 2 * hstep;
    const unsigned ldsw = (unsigned)wid * 1024u;
    const int aoff = lds_byte(wr * 64 + fr, fq * 8), boff = lds_byte(wc * 32 + fr, fq * 8);
#define PG8_SA(b, h) (((b) * 2 + (h)) * HTB)
#define PG8_SB(b, h) ((4 + (b) * 2 + (h)) * HTB)
#define PG8_STAGE(bufoff, gbase, voff) do { _Pragma("unroll") for (int _i = 0; _i < 2; ++_i) \
        __builtin_amdgcn_global_load_lds((const unsigned*)((const char*)(gbase) + (voff)[_i]), (PG8_LAS unsigned*)(lds + (bufoff) + ldsw + _i * 8192), 16, 0, 0); } while (0)
#define PG8_LDA(dst, b, h) do { _Pragma("unroll") for (int m = 0; m < 4; ++m) _Pragma("unroll") for (int k = 0; k < 2; ++k) dst[m][k] = *(const PG8_LAS bf16x8*)(lds + PG8_SA(b, h) + aoff + m * 2048 + k * 1024); } while (0)
#define PG8_LDB(dst, b, h) do { _Pragma("unroll") for (int n = 0; n < 2; ++n) _Pragma("unroll") for (int k = 0; k < 2; ++k) dst[n][k] = *(const PG8_LAS bf16x8*)(lds + PG8_SB(b, h) + boff + n * 2048 + k * 1024); } while (0)
#define PG8_MMA(ai, bj, At, Bt) do { __builtin_amdgcn_s_setprio(1); _Pragma("unroll") for (int m = 0; m < 4; ++m) _Pragma("unroll") for (int n = 0; n < 2; ++n) _Pragma("unroll") for (int k = 0; k < 2; ++k) \
        acc[ai][bj][m][n] = __builtin_amdgcn_mfma_f32_16x16x32_bf16(Bt[n][k], At[m][k], acc[ai][bj][m][n], 0, 0, 0); __builtin_amdgcn_s_setprio(0); } while (0)
#define PG8_WAIT_V(n) asm volatile("s_waitcnt vmcnt(" #n ")" ::: "memory")
#define PG8_WAIT_L(n) asm volatile("s_waitcnt lgkmcnt(" #n ")" ::: "memory")
#define PG8_BAR __builtin_amdgcn_s_barrier()
#define PG8_SCHED __builtin_amdgcn_sched_barrier(0)
    Unit cur, nxt; int ui = 0;
    if (!S.next(0, cur)) return;
    f32x4 acc[2][2][4][2];
#pragma unroll
    for (int a = 0; a < 2; ++a)
#pragma unroll
        for (int b = 0; b < 2; ++b)
#pragma unroll
            for (int m = 0; m < 4; ++m)
#pragma unroll
                for (int n = 0; n < 2; ++n) acc[a][b][m][n] = (f32x4){0.f, 0.f, 0.f, 0.f};
    bf16x8 At[4][2], B0[2][2], B1[2][2];
    auto abase = [&](int pm) -> size_t { return g.bsA ? (size_t)(pm >> 3) * g.bsA + (size_t)(pm & 7) * tstep : (size_t)pm * tstep; };
    const char* cA = (const char*)g.A + abase(cur.pm); const char* cB = (const char*)g.Bt + (size_t)cur.pn * tstep;
    S.a_ready(cur);
    if constexpr (SP2) {
        PG8_STAGE(PG8_SB(0, 0), cB, voffB); PG8_STAGE(PG8_SB(0, 1), cB + hstep, voffB); PG8_STAGE(PG8_SA(0, 0), cA, voffA); PG8_STAGE(PG8_SA(0, 1), cA + hstep, voffA);
        if (wr == 1) PG8_BAR;
        PG8_WAIT_V(2); PG8_BAR;
        PG8_STAGE(PG8_SB(1, 0), cB + kstep, voffB); PG8_STAGE(PG8_SA(1, 0), cA + kstep, voffA); PG8_STAGE(PG8_SB(1, 1), cB + hstep + kstep, voffB);
        PG8_WAIT_V(6); PG8_BAR;
    } else {
        PG8_STAGE(PG8_SB(0, 0), cB, voffB); PG8_STAGE(PG8_SA(0, 0), cA, voffA); PG8_STAGE(PG8_SB(0, 1), cB + hstep, voffB); PG8_STAGE(PG8_SA(0, 1), cA + hstep, voffA);
        if (wr == 1) PG8_BAR;
        PG8_WAIT_V(4); PG8_BAR;
        PG8_STAGE(PG8_SB(1, 0), cB + kstep, voffB); PG8_STAGE(PG8_SA(1, 0), cA + kstep, voffA); PG8_STAGE(PG8_SB(1, 1), cB + hstep + kstep, voffB);
        PG8_WAIT_V(6); PG8_BAR;
    }
    for (;;) {
        const bool has_next = S.next(ui + 1, nxt);
        const char* nA = has_next ? (const char*)g.A + abase(nxt.pm) : cA; const char* nB = has_next ? (const char*)g.Bt + (size_t)nxt.pn * tstep : cB;
        for (int t = 0; t < nt; t += 2) {
            const bool last = (t == nt - 2);
            const char* a1 = cA + (size_t)(t + 1) * kstep;
            const char* a2 = last ? nA : cA + (size_t)(t + 2) * kstep; const char* b2 = last ? nB : cB + (size_t)(t + 2) * kstep;
            const char* a3 = a2 + kstep; const char* b3 = b2 + kstep;
            if (last && has_next) S.a_ready(nxt);
            if constexpr (SP2) {
            PG8_LDB(B0, 0, 0); PG8_LDB(B1, 0, 1); PG8_SCHED; PG8_LDA(At, 0, 0); PG8_STAGE(PG8_SA(1, 1), a1 + hstep, voffA);
            PG8_WAIT_V(8); PG8_WAIT_L(0); PG8_BAR; PG8_MMA(0, 0, At, B0); PG8_MMA(0, 1, At, B1); PG8_BAR; PG8_SCHED;
            PG8_LDA(At, 0, 1); PG8_STAGE(PG8_SB(0, 0), b2, voffB); PG8_STAGE(PG8_SB(0, 1), b2 + hstep, voffB); PG8_STAGE(PG8_SA(0, 0), a2, voffA);
            PG8_WAIT_V(8); PG8_WAIT_L(0); PG8_BAR; PG8_MMA(1, 0, At, B0); PG8_MMA(1, 1, At, B1); PG8_BAR; PG8_SCHED;
            PG8_LDB(B0, 1, 0); PG8_LDB(B1, 1, 1); PG8_SCHED; PG8_LDA(At, 1, 0); PG8_STAGE(PG8_SA(0, 1), a2 + hstep, voffA);
            PG8_WAIT_V(8); PG8_WAIT_L(0); PG8_BAR; PG8_MMA(0, 0, At, B0); PG8_MMA(0, 1, At, B1); PG8_BAR; PG8_SCHED;
            PG8_LDA(At, 1, 1); PG8_STAGE(PG8_SB(1, 0), b3, voffB); PG8_STAGE(PG8_SB(1, 1), b3 + hstep, voffB); PG8_STAGE(PG8_SA(1, 0), a3, voffA);
            PG8_WAIT_V(8); PG8_WAIT_L(0); PG8_BAR; PG8_MMA(1, 0, At, B0); PG8_MMA(1, 1, At, B1); PG8_BAR; PG8_SCHED;
            } else {
            PG8_LDB(B0, 0, 0); PG8_SCHED; PG8_LDA(At, 0, 0); PG8_STAGE(PG8_SA(1, 1), a1 + hstep, voffA);
            PG8_WAIT_L(8); PG8_BAR; PG8_WAIT_L(0); PG8_MMA(0, 0, At, B0); PG8_BAR; PG8_SCHED;
            PG8_LDB(B1, 0, 1); PG8_STAGE(PG8_SB(0, 0), b2, voffB);
            PG8_BAR; PG8_WAIT_L(0); PG8_MMA(0, 1, At, B1); PG8_BAR;
            PG8_LDA(At, 0, 1); PG8_STAGE(PG8_SA(0, 0), a2, voffA);
            PG8_BAR; PG8_WAIT_L(0); PG8_MMA(1, 0, At, B0); PG8_BAR; PG8_SCHED;
            PG8_STAGE(PG8_SB(0, 1), b2 + hstep, voffB);
            PG8_WAIT_V(6); PG8_BAR; PG8_MMA(1, 1, At, B1); PG8_BAR;
            PG8_LDB(B0, 1, 0); PG8_SCHED; PG8_LDA(At, 1, 0); PG8_STAGE(PG8_SA(0, 1), a2 + hstep, voffA);
            PG8_WAIT_L(8); PG8_BAR; PG8_WAIT_L(0); PG8_MMA(0, 0, At, B0); PG8_BAR; PG8_SCHED;
            PG8_LDB(B1, 1, 1); PG8_STAGE(PG8_SB(1, 0), b3, voffB);
            PG8_BAR; PG8_WAIT_L(0); PG8_MMA(0, 1, At, B1); PG8_BAR;
            PG8_LDA(At, 1, 1); PG8_STAGE(PG8_SA(1, 0), a3, voffA);
            PG8_BAR; PG8_WAIT_L(0); PG8_MMA(1, 0, At, B0); PG8_BAR; PG8_SCHED;
            PG8_STAGE(PG8_SB(1, 1), b3 + hstep, voffB);
            PG8_WAIT_V(6); PG8_BAR; PG8_MMA(1, 1, At, B1); PG8_BAR;
            }
        }
        if constexpr (ALIGN_EPI) { if (wr == 0) PG8_BAR; }
        if constexpr (!Epi::AFTER_DRAIN) { E(acc, cur, wr, wc, fr, fq); S.done(cur); }
        if (!has_next) break;
#pragma unroll
        for (int a = 0; a < 2; ++a)
#pragma unroll
            for (int b = 0; b < 2; ++b)
#pragma unroll
                for (int m = 0; m < 4; ++m)
#pragma unroll
                    for (int n = 0; n < 2; ++n) acc[a][b][m][n] = (f32x4){0.f, 0.f, 0.f, 0.f};
        cur = nxt; cA = nA; cB = nB; ++ui;
        if constexpr (ALIGN_EPI) { if (wr == 1) PG8_BAR; }
    }
    PG8_WAIT_V(0);
    if constexpr (!ALIGN_EPI) { if (wr == 0) PG8_BAR; }
    PG8_BAR;
#undef PG8_SA
#undef PG8_SB
#undef PG8_STAGE
#undef PG8_LDA
#undef PG8_LDB
#undef PG8_MMA
#undef PG8_WAIT_V
#undef PG8_WAIT_L
#undef PG8_BAR
#undef PG8_SCHED
}
}

#ifndef PG8_SP2
#define PG8_SP2 true
#endif
#ifndef PG8_ALIGN
#define PG8_ALIGN true
#endif

constexpr int NWAVES = 8;
constexpr int NPH = 17;
constexpr int N_LAUNCHES = MK_N_LAUNCHES;
static_assert(N_LAUNCHES == 1 || N_LAUNCHES == NPH, "MK_N_LAUNCHES is 1 or NPH");

constexpr int D = 4096, SEQ = 2048, BATCH = 8, M = BATCH * SEQ;
constexpr int FF = 11008, NGU = 2 * FF;
constexpr int EV_IN = 8208, N0 = 8192, OD_IN = 16384;
constexpr int S5W = 2048, S5G = 128;
constexpr float DN_ALPHA = 1.41421356237f;
constexpr float NORM_EPS = 1e-5f;

constexpr size_t MiB = 1u << 20;
constexpr size_t WS_CTL = 0, CTL_ZERO_BYTES = 1 * MiB;
constexpr size_t WS_WAF = 1 * MiB;
constexpr size_t WS_AB = WS_WAF + 128 * 1024;
constexpr size_t WS_BBF = WS_AB + 64 * 1024;
constexpr size_t WS_CRF = WS_BBF + 1 * MiB;
constexpr size_t WS_STATS = 2 * MiB + 768 * 1024;
constexpr size_t WS_ALR = 3 * MiB;
constexpr size_t WS_W_IN0 = 4 * MiB, WS_W_GLU = 68 * MiB, WS_W_OUT0 = 76 * MiB, WS_W_GU0 = 108 * MiB, WS_W_DN0 = 280 * MiB;
constexpr size_t WS_W_IN1 = 366 * MiB, WS_W_OUT1 = 494 * MiB, WS_W_GU1 = 526 * MiB, WS_W_DN1 = 698 * MiB;
constexpr size_t WS_XB = 784 * MiB;
constexpr size_t WS_YCAT = WS_XB;
constexpr size_t WS_H = 912 * MiB;
constexpr size_t WS_Z = WS_H + 512 * MiB;
constexpr size_t WS_YG = WS_Z + 128 * MiB;
constexpr size_t HSLAB_EL = (size_t)32 * 1024 * 1024;
constexpr size_t WS_GDEC = WS_Z + 256 * MiB;
constexpr size_t WS_END = WS_GDEC + 64 * MiB;
static_assert(WS_CRF + 512 * 1024 <= WS_STATS && WS_STATS + 128 * 1024 <= WS_ALR, "tables");
static_assert(WS_W_GU0 + (size_t)NGU * D * 2 <= WS_W_DN0 && WS_W_DN0 + (size_t)D * FF * 2 <= WS_W_IN1 && WS_W_GU1 + (size_t)NGU * D * 2 <= WS_W_DN1 && WS_W_DN1 + (size_t)D * FF * 2 <= WS_XB, "weights");
static_assert(WS_H + (size_t)M * OD_IN * 2 <= WS_Z && WS_Z + (size_t)M * D * 4 <= WS_END, "h");

constexpr int CW_TMO = 0, CW_CODE = 1;
constexpr int CW_BAR = 4096;

constexpr int RING_OFF = 0, RING_BYTES = 131072;
constexpr int LDSCTL_OFF = RING_BYTES, MISC_OFF = LDSCTL_OFF + 320;
constexpr int LDS_BYTES = 147456;
static_assert(MISC_OFF + 128 <= LDS_BYTES, "LDS map");

#define GAS __attribute__((address_space(1)))
#define LAS __attribute__((address_space(3)))
typedef unsigned short bf16;
typedef unsigned v4u __attribute__((ext_vector_type(4)));
typedef unsigned v2u __attribute__((ext_vector_type(2)));
typedef float f32x4 __attribute__((ext_vector_type(4)));
typedef float f32x2 __attribute__((ext_vector_type(2)));
typedef short bf16x8 __attribute__((ext_vector_type(8)));
typedef GAS unsigned gu32;
#define RLX_AGENT __ATOMIC_RELAXED, __HIP_MEMORY_SCOPE_AGENT
#define LDS_WAIT() asm volatile("s_waitcnt lgkmcnt(0)" ::: "memory")
#define VM_WAIT() asm volatile("s_waitcnt vmcnt(0)" ::: "memory")
#define CFENCE() asm volatile("" ::: "memory")
__device__ __forceinline__ unsigned pk2(float lo, float hi) { return pg8::cvt_pk_bf16(lo, hi); }
__device__ __forceinline__ float bflo(unsigned x) { return __uint_as_float(x << 16); }
__device__ __forceinline__ float bfhi(unsigned x) { return __uint_as_float(x & 0xffff0000u); }
__device__ __forceinline__ f32x4 mfma16(bf16x8 a, bf16x8 b, f32x4 c) { return __builtin_amdgcn_mfma_f32_16x16x32_bf16(a, b, c, 0, 0, 0); }

#define XB_TMO      128
#define XB_XCNT(j)  (256  + 64 * (j))
#define XB_XSUB(j)  (1280 + 64 * (j))
#define XB_XGEN(j)  (2304 + 64 * (j))
#define XB_TOP      3328
#define XB_TOPGEN   3392
#define XCD_BAR_WORDS 3456
#define XB_SPIN_CAP (1u << 18)

__device__ __forceinline__ unsigned xb_ld(unsigned* p)              { return __hip_atomic_load(p, __ATOMIC_RELAXED, __HIP_MEMORY_SCOPE_AGENT); }
__device__ __forceinline__ unsigned xb_add(unsigned* p, unsigned v) { return __hip_atomic_fetch_add(p, v, __ATOMIC_RELAXED, __HIP_MEMORY_SCOPE_AGENT); }
__device__ __forceinline__ unsigned xb_xcc_id() { return (unsigned)__builtin_amdgcn_s_getreg((3 << 11) | 20) & 0xFu; }
#define XB_SPIN(cond, bar) do { unsigned _sp = 0; while (cond) { __builtin_amdgcn_s_sleep(1); \
    if ((++_sp & 255u) == 0u) { if (xb_ld(&(bar)[XB_TMO])) break; if (_sp > XB_SPIN_CAP) { atomicAdd(&(bar)[XB_TMO], 1u); break; } } } } while (0)

struct XcdBarrier {
    unsigned* bar; unsigned x;
    volatile LAS unsigned* st;
};
__device__ __forceinline__ XcdBarrier xcd_barrier_post(unsigned* bar, volatile LAS unsigned* st) {
    XcdBarrier b; b.bar = bar; b.x = xb_xcc_id(); b.st = st;
    if (threadIdx.x == 0) (void)xb_add(&bar[XB_XCNT(b.x)], 1u);
    return b;
}
__device__ __forceinline__ void xcd_barrier_complete(unsigned* bar, unsigned x, unsigned& nloc, unsigned& nx) {
    const unsigned G = gridDim.x * gridDim.y * gridDim.z;
    unsigned sum, cnt, mine, sp = 0u;
    for (;;) {
        sum = 0u; cnt = 0u; mine = 0u;
#pragma unroll
        for (unsigned j = 0; j < 16; ++j) { const unsigned c = xb_ld(&bar[XB_XCNT(j)]); sum += c; cnt += (c > 0u) ? 1u : 0u; mine = (j == x) ? c : mine; }
        if (sum == G) break;
        __builtin_amdgcn_s_sleep(1);
        if ((++sp & 255u) == 0u) { if (xb_ld(&bar[XB_TMO])) break; if (sp > XB_SPIN_CAP) { atomicAdd(&bar[XB_TMO], 1u); break; } }
    }
    nloc = mine > 0u ? mine : 1u; nx = cnt > 0u ? cnt : 1u;
}
__device__ __forceinline__ void xcd_barrier(const XcdBarrier& b, const bool local = false) {
    asm volatile("s_waitcnt vmcnt(0)" ::: "memory");
    __syncthreads();
    if (threadIdx.x == 0) {
        unsigned* bar = b.bar;
        __builtin_amdgcn_s_waitcnt(0);
        unsigned nloc = b.st[0], nx = b.st[1];
        if (nloc == 0u) { xcd_barrier_complete(bar, b.x, nloc, nx); b.st[0] = nloc; b.st[1] = nx; }
        const unsigned old = xb_add(&bar[XB_XSUB(b.x)], 1u);
        const unsigned gen = old / nloc;
        if (old + 1u == (gen + 1u) * nloc) {
            if (!local) {
                __builtin_amdgcn_fence(__ATOMIC_RELEASE, "agent");
                asm volatile("s_waitcnt vmcnt(0)" ::: "memory");
                const unsigned og = xb_add(&bar[XB_TOP], 1u);
                const unsigned tg = og / nx;
                if (og + 1u == (tg + 1u) * nx) xb_add(&bar[XB_TOPGEN], 1u);
                else XB_SPIN(xb_ld(&bar[XB_TOPGEN]) == tg, bar);
            }
            __builtin_amdgcn_fence(__ATOMIC_ACQUIRE, "agent");
            xb_add(&bar[XB_XGEN(b.x)], 1u);
            asm volatile("s_waitcnt vmcnt(0)" ::: "memory");
        } else {
            XB_SPIN(xb_ld(&bar[XB_XGEN(b.x)]) == gen, bar);
            __builtin_amdgcn_fence(__ATOMIC_ACQUIRE, "agent");
            asm volatile("s_waitcnt vmcnt(0)" ::: "memory");
        }
    }
    __syncthreads();
}

struct Args { const float* in[26]; float* out; unsigned char* ws; int ph_lo, ph_hi, li, pad; };
struct Frame {
    LAS unsigned char* lds;
    volatile LAS unsigned* MISC;
    gu32* ctl;
    int tid, lane, wave;
    int vcu, G;
    float* out;
    unsigned char* ws;
};
enum { I_X = 0, I_EV_W_IN, I_EV_W_OUT, I_S5_LAM_RE, I_S5_LAM_IM, I_S5_LOG_DT, I_S5_B_RE, I_S5_B_IM, I_S5_C_RE, I_S5_C_IM, I_S5_D, I_S5_W_GLU,
       I_GLA_W_ALPHA, I_GLA_B_ALPHA, I_GLA_NORM_G, I_OD_W_IN, I_OD_W_OUT, I_HG_LB, I_HG_NORM_G, I_LN_MIX_G, I_LN_MIX_B, I_LN_FFN_G, I_LN_FFN_B,
       I_FFN_W_GATE, I_FFN_W_UP, I_FFN_W_DOWN };

__device__ __forceinline__ float wave_sum(float v) {
#pragma unroll
    for (int o = 1; o < 64; o <<= 1) v += __shfl_xor(v, o);
    return v;
}

struct P0Item { const GAS float* src; size_t ldw; bf16* dst; size_t K8; };
__device__ __forceinline__ void p0_item_make(P0Item& d, const float* W, int K, int ldw, int nblk, bf16* WT, int mode, int item, int lane) {
    const int kb_ = item / nblk, nb = item - kb_ * nblk, k0 = 64 * kb_, n0 = 64 * nb;
    const int ng = lane & 15, kg = lane >> 4;
    d.src = (const GAS float*)W + (size_t)(k0 + 16 * kg) * ldw + n0 + 4 * ng; d.ldw = (size_t)ldw;
    const int rbase = (mode == 0) ? n0 : ((n0 >> 7) * 256 + (n0 & 127) + (mode == 2 ? 128 : 0));
    d.dst = WT + (size_t)(rbase + (lane >> 3)) * K + k0 + 8 * (lane & 7); d.K8 = (size_t)8 * K;
}
__device__ __forceinline__ void p0_item_load(const P0Item& d, f32x4 (&v)[2][8]) {
#pragma unroll
    for (int kb = 0; kb < 2; ++kb)
#pragma unroll
        for (int i = 0; i < 8; ++i) v[kb][i] = __builtin_nontemporal_load((const GAS f32x4*)(d.src + (size_t)(8 * kb + i) * d.ldw));
}
__device__ __forceinline__ void p0_item_finish(const P0Item& d, const f32x4 (&v)[2][8], LAS bf16* img, int lane) {
    const int ng = lane & 15, kg = lane >> 4;
#pragma unroll
    for (int kb = 0; kb < 2; ++kb)
#pragma unroll
        for (int j = 0; j < 4; ++j) {
            v4u o; o.x = pk2(v[kb][0][j], v[kb][1][j]); o.y = pk2(v[kb][2][j], v[kb][3][j]); o.z = pk2(v[kb][4][j], v[kb][5][j]); o.w = pk2(v[kb][6][j], v[kb][7][j]);
            *(LAS v4u*)(img + (4 * ng + j) * 72 + 16 * kg + 8 * kb) = o;
        }
    LDS_WAIT(); CFENCE();
#pragma unroll
    for (int j = 0; j < 8; ++j) { const int n = (lane >> 3) + 8 * j, c = lane & 7;
        const v4u o = *(const LAS v4u*)(img + n * 72 + 8 * c);
        *(GAS v4u*)(d.dst + (size_t)j * d.K8) = o; }
    LDS_WAIT(); CFENCE();
}

__device__ __forceinline__ void s5_disc(const Args& A, int g, int p, double& ar, double& ai, double& fr, double& fi) {
    const double dt = exp((double)A.in[I_S5_LOG_DT][g]);
    const double lr = (double)A.in[I_S5_LAM_RE][g * 64 + p], li = (double)A.in[I_S5_LAM_IM][g * 64 + p];
    const double mag = exp(lr * dt), th = li * dt;
    ar = mag * cos(th); ai = mag * sin(th);
    const double nr = ar - 1.0, ni = ai, den = lr * lr + li * li;
    fr = (nr * lr + ni * li) / den; fi = (ni * lr - nr * li) / den;
}

constexpr int IT_IN0 = (D / 64) * (N0 / 64), IT_GLU = (S5W / 64) * (S5W / 64), IT_OUT = (D / 64) * (D / 64), IT_G = (D / 64) * (FF / 64), IT_DN = (FF / 64) * (D / 64), IT_IN1 = (D / 64) * (OD_IN / 64);
constexpr int NITEMS = IT_IN0 + IT_GLU + 2 * IT_OUT + 4 * IT_G + 2 * IT_DN + IT_IN1;
constexpr int NITEMS_P14 = NITEMS - IT_DN;
constexpr int NITEMS_P7 = NITEMS_P14 - IT_G;
constexpr int NITEMS_P3B = NITEMS_P7 - IT_IN1 - IT_OUT - IT_DN;
constexpr int NITEMS_EARLY = NITEMS_P3B - IT_G;
__device__ __forceinline__ void p0a_phase(Frame& F, const Args& A, const bool tables, const int gw, const int NGW, const int it_lo, const int it_hi) {
    LAS bf16* scr = (LAS bf16*)(F.lds + RING_OFF + F.wave * 16384);
    if (tables) {
        const int gt = (F.vcu * NWAVES * 64) + F.tid;
        if (gt < 65536) {
            const int g = gt >> 9, n = (gt >> 6) & 7, l = gt & 63, q = l >> 4, pr = 16 * n + (l & 15);
            v4u o = (v4u){0u, 0u, 0u, 0u};
            if (q < 2) {
                const int p = pr & 63; double ar, ai, fr, fi; s5_disc(A, g, p, ar, ai, fr, fi);
                const float* bre = A.in[I_S5_B_RE] + ((size_t)g * 64 + p) * 16 + 8 * q; const float* bim = A.in[I_S5_B_IM] + ((size_t)g * 64 + p) * 16 + 8 * q;
                float v[8];
#pragma unroll
                for (int e = 0; e < 8; ++e) { const double br = bre[e], bi = bim[e]; v[e] = (float)((pr < 64) ? (fr * br - fi * bi) : (fr * bi + fi * br)); }
                o.x = pk2(v[0], v[1]); o.y = pk2(v[2], v[3]); o.z = pk2(v[4], v[5]); o.w = pk2(v[6], v[7]);
            }
            *(GAS v4u*)(F.ws + WS_BBF + (size_t)gt * 16) = o;
        } else if (gt < 65536 + 32768) {
            const int t = gt - 65536, g = t >> 8, ks = (t >> 6) & 3, l = t & 63, q = l >> 4, i = l & 15;
            float v[8];
#pragma unroll
            for (int e = 0; e < 8; ++e) { const int pp = 32 * ks + 8 * q + e; v[e] = (pp < 64) ? A.in[I_S5_C_RE][((size_t)g * 16 + i) * 64 + pp] : -A.in[I_S5_C_IM][((size_t)g * 16 + i) * 64 + (pp - 64)]; }
            v4u o; o.x = pk2(v[0], v[1]); o.y = pk2(v[2], v[3]); o.z = pk2(v[4], v[5]); o.w = pk2(v[6], v[7]);
            *(GAS v4u*)(F.ws + WS_CRF + (size_t)t * 16) = o;
        } else if (gt < 65536 + 32768 + 8192) {
            const int t = gt - 98304, g = t >> 6, p = t & 63; double ar, ai, fr, fi; s5_disc(A, g, p, ar, ai, fr, fi);
            *(GAS f32x2*)(F.ws + WS_AB + (size_t)t * 8) = (f32x2){(float)ar, (float)ai};
        } else if (gt < 65536 + 32768 + 8192 + 8192) {
            const int t = gt - 106496, ks = t >> 6, l = t & 63, q = l >> 4, n = l & 15;
            float v[8];
#pragma unroll
            for (int e = 0; e < 8; ++e) v[e] = A.in[I_EV_W_IN][(size_t)(32 * ks + 8 * q + e) * EV_IN + N0 + n];
            v4u o; o.x = pk2(v[0], v[1]); o.y = pk2(v[2], v[3]); o.z = pk2(v[4], v[5]); o.w = pk2(v[6], v[7]);
            *(GAS v4u*)(F.ws + WS_WAF + (size_t)t * 16) = o;
        }
    }
    auto decode = [&](int it, P0Item& d) {
        int r = it;
        if (r < IT_IN0) { p0_item_make(d, A.in[I_EV_W_IN], D, EV_IN, N0 / 64, (bf16*)(F.ws + WS_W_IN0), 0, r, F.lane); return; } r -= IT_IN0;
        if (r < IT_GLU) { p0_item_make(d, A.in[I_S5_W_GLU], S5W, S5W, S5W / 64, (bf16*)(F.ws + WS_W_GLU), 0, r, F.lane); return; } r -= IT_GLU;
        if (r < IT_OUT) { p0_item_make(d, A.in[I_EV_W_OUT], D, D, D / 64, (bf16*)(F.ws + WS_W_OUT0), 0, r, F.lane); return; } r -= IT_OUT;
        if (r < IT_G) { p0_item_make(d, A.in[I_FFN_W_GATE], D, FF, FF / 64, (bf16*)(F.ws + WS_W_GU0), 1, r, F.lane); return; } r -= IT_G;
        if (r < IT_G) { p0_item_make(d, A.in[I_FFN_W_UP], D, FF, FF / 64, (bf16*)(F.ws + WS_W_GU0), 2, r, F.lane); return; } r -= IT_G;
        if (r < IT_G) { p0_item_make(d, A.in[I_FFN_W_UP] + (size_t)D * FF, D, FF, FF / 64, (bf16*)(F.ws + WS_W_GU1), 2, r, F.lane); return; } r -= IT_G;
        if (r < IT_DN) { p0_item_make(d, A.in[I_FFN_W_DOWN], FF, D, D / 64, (bf16*)(F.ws + WS_W_DN0), 0, r, F.lane); return; } r -= IT_DN;
        if (r < IT_OUT) { p0_item_make(d, A.in[I_OD_W_OUT], D, D, D / 64, (bf16*)(F.ws + WS_W_OUT1), 0, r, F.lane); return; } r -= IT_OUT;
        if (r < IT_IN1) { p0_item_make(d, A.in[I_OD_W_IN], D, OD_IN, OD_IN / 64, (bf16*)(F.ws + WS_W_IN1), 0, r, F.lane); return; } r -= IT_IN1;
        if (r < IT_G) { p0_item_make(d, A.in[I_FFN_W_GATE] + (size_t)D * FF, D, FF, FF / 64, (bf16*)(F.ws + WS_W_GU1), 1, r, F.lane); return; } r -= IT_G;
        p0_item_make(d, A.in[I_FFN_W_DOWN] + (size_t)FF * D, FF, D, D / 64, (bf16*)(F.ws + WS_W_DN1), 0, r, F.lane);
    };
    int it = it_lo + gw;
    if (it < it_hi) {
        P0Item d0, d1, d2; f32x4 v0[2][8], v1[2][8], v2[2][8];
        decode(it, d0); p0_item_load(d0, v0);
        bool h1 = it + NGW < it_hi;
        if (h1) { decode(it + NGW, d1); p0_item_load(d1, v1); }
        for (;;) {
            bool h2 = h1 && (it + 2 * NGW < it_hi);
            if (h2) { decode(it + 2 * NGW, d2); p0_item_load(d2, v2); }
            p0_item_finish(d0, v0, scr, F.lane);
            if (!h1) break;
            it += NGW;
            bool h0 = h2 && (it + 2 * NGW < it_hi);
            if (h0) { decode(it + 2 * NGW, d0); p0_item_load(d0, v0); }
            p0_item_finish(d1, v1, scr, F.lane);
            if (!h2) break;
            it += NGW;
            h1 = h0 && (it + 2 * NGW < it_hi);
            if (h1) { decode(it + 2 * NGW, d1); p0_item_load(d1, v1); }
            p0_item_finish(d2, v2, scr, F.lane);
            if (!h0) break;
            it += NGW;
        }
    }
}

__device__ __forceinline__ void p0b_phase(Frame& F, const Args& A) {
    const int lane = F.lane, fr = lane & 15, fq = lane >> 4, w = F.wave;
    LAS float* red = (LAS float*)(F.lds + RING_OFF);
    const bf16* waf = (const bf16*)(F.ws + WS_WAF);
    bf16* XB = (bf16*)(F.ws + WS_XB);
    float* ALR = (float*)(F.ws + WS_ALR);
    float* GD = (float*)(F.ws + WS_GDEC);
    LAS float* alr_l = red + 1024;
    f32x2 wa[16];
#pragma unroll
    for (int r = 0; r < 16; ++r) wa[r] = *(const GAS f32x2*)(A.in[I_GLA_W_ALPHA] + r * 1024 + 2 * F.tid);
    const f32x2 ba2 = *(const GAS f32x2*)(A.in[I_GLA_B_ALPHA] + 2 * F.tid);
    for (int tb = F.vcu; tb < M / 64; tb += F.G) {
        const int row0 = 16 * (4 * tb + (w & 3)), kh = w >> 2;
        const float* xr = A.in[I_X] + (size_t)(row0 + fr) * D + 8 * fq;
        bf16* xo = XB + (size_t)(row0 + fr) * D + 8 * fq;
        f32x4 acc = (f32x4){0.f, 0.f, 0.f, 0.f};
#pragma unroll 4
        for (int ks = 64 * kh; ks < 64 * kh + 64; ++ks) {
            const f32x4 a0 = __builtin_nontemporal_load((const GAS f32x4*)(xr + 32 * ks)), a1 = __builtin_nontemporal_load((const GAS f32x4*)(xr + 32 * ks + 4));
            v4u pa; pa.x = pk2(a0[0], a0[1]); pa.y = pk2(a0[2], a0[3]); pa.z = pk2(a1[0], a1[1]); pa.w = pk2(a1[2], a1[3]);
            *(GAS v4u*)(xo + 32 * ks) = pa;
            const v4u pb = *(const GAS v4u*)(waf + ((size_t)ks * 64 + lane) * 8);
            acc = mfma16(__builtin_bit_cast(bf16x8, pa), __builtin_bit_cast(bf16x8, pb), acc);
        }
        if (kh == 1) *(LAS f32x4*)(red + ((w & 3) * 64 + lane) * 4) = acc;
        __syncthreads();
        if (kh == 0) { const f32x4 o = acc + *(LAS f32x4*)(red + ((w & 3) * 64 + lane) * 4);
#pragma unroll
            for (int r = 0; r < 4; ++r) { ALR[(size_t)(row0 + 4 * fq + r) * 16 + fr] = o[r]; alr_l[(16 * (w & 3) + 4 * fq + r) * 16 + fr] = o[r]; } }
        __syncthreads();
        for (int t = 0; t < 64; ++t) {
            float z0 = ba2.x, z1 = ba2.y;
#pragma unroll
            for (int r4 = 0; r4 < 4; ++r4) { const f32x4 t4 = *(const LAS f32x4*)(alr_l + t * 16 + 4 * r4);
                z0 += t4.x * wa[4 * r4].x + t4.y * wa[4 * r4 + 1].x + t4.z * wa[4 * r4 + 2].x + t4.w * wa[4 * r4 + 3].x;
                z1 += t4.x * wa[4 * r4].y + t4.y * wa[4 * r4 + 1].y + t4.z * wa[4 * r4 + 2].y + t4.w * wa[4 * r4 + 3].y; }
            const float l0 = __log2f(1.f + __expf(-z0)), l1 = __log2f(1.f + __expf(-z1));
            *(GAS f32x2*)(GD + (size_t)(64 * tb + t) * 1024 + 2 * F.tid) = (f32x2){__builtin_amdgcn_exp2f(l0 * (-1.f / 16.f)), __builtin_amdgcn_exp2f(l1 * (-1.f / 16.f))};
        }
        __syncthreads();
    }
}

__device__ __forceinline__ void ln_phase(Frame& F, const bf16* z, const float* gam, const float* bet, float* outf, bf16* outb, float* stats) {
    const int RPW = M / (F.G * NWAVES), gw = (F.vcu * NWAVES + F.wave) * RPW, NGW = 1, MEND = gw + RPW;
    LAS float* gl = (LAS float*)(F.lds + RING_OFF); LAS float* bl = gl + D;
    for (int i = F.tid; i < D / 4; i += NWAVES * 64) { *(LAS f32x4*)(gl + 4 * i) = *(const GAS f32x4*)(gam + 4 * i); *(LAS f32x4*)(bl + 4 * i) = *(const GAS f32x4*)(bet + 4 * i); }
    __syncthreads();
    v4u pre[8];
    if (gw < M) { const GAS v4u* zr = (const GAS v4u*)(z + (size_t)gw * D) + F.lane;
#pragma unroll
        for (int j = 0; j < 8; ++j) pre[j] = zr[64 * j]; }
    for (int m = gw; m < MEND; m += NGW) {
        float v[8][8]; float s = 0.f;
#pragma unroll
        for (int j = 0; j < 8; ++j) { const v4u p = pre[j];
            v[j][0] = pg8::hflo(p.x); v[j][1] = pg8::hfhi(p.x); v[j][2] = pg8::hflo(p.y); v[j][3] = pg8::hfhi(p.y); v[j][4] = pg8::hflo(p.z); v[j][5] = pg8::hfhi(p.z); v[j][6] = pg8::hflo(p.w); v[j][7] = pg8::hfhi(p.w);
            s += ((v[j][0] + v[j][1]) + (v[j][2] + v[j][3])) + ((v[j][4] + v[j][5]) + (v[j][6] + v[j][7])); }
        if (m + NGW < MEND) { const GAS v4u* zn = (const GAS v4u*)(z + (size_t)(m + NGW) * D) + F.lane;
#pragma unroll
            for (int j = 0; j < 8; ++j) pre[j] = zn[64 * j]; }
        const float mean = wave_sum(s) * (1.f / D); float s2 = 0.f;
#pragma unroll
        for (int j = 0; j < 8; ++j)
#pragma unroll
            for (int e = 0; e < 8; ++e) { v[j][e] -= mean; s2 += v[j][e] * v[j][e]; }
        const float rstd = 1.f / sqrtf(wave_sum(s2) * (1.f / D) + NORM_EPS);
        if (stats && F.lane == 0) *(GAS f32x2*)(stats + 2 * m) = (f32x2){mean, rstd};
#pragma unroll
        for (int j = 0; j < 8; ++j) { const int e0 = 8 * (F.lane + 64 * j);
            const f32x4 g0 = *(const LAS f32x4*)(gl + e0), g1 = *(const LAS f32x4*)(gl + e0 + 4), b0 = *(const LAS f32x4*)(bl + e0), b1 = *(const LAS f32x4*)(bl + e0 + 4);
            const f32x4 o0 = (f32x4){v[j][0], v[j][1], v[j][2], v[j][3]} * rstd * g0 + b0, o1 = (f32x4){v[j][4], v[j][5], v[j][6], v[j][7]} * rstd * g1 + b1;
            if (outf) { __builtin_nontemporal_store(o0, (GAS f32x4*)(outf + (size_t)m * D + e0)); __builtin_nontemporal_store(o1, (GAS f32x4*)(outf + (size_t)m * D + e0 + 4)); }
            if (outb) { v4u pb; pb.x = pk2(o0.x, o0.y); pb.y = pk2(o0.z, o0.w); pb.z = pk2(o1.x, o1.y); pb.w = pk2(o1.z, o1.w); *(GAS v4u*)(outb + (size_t)m * D + e0) = pb; } }
    }
    __syncthreads();
}

__device__ __forceinline__ float gelu_tanh(float y) {
    const float a = 0.7978845608028654f * (y + 0.044715f * y * y * y);
    const float e = __expf(2.f * a);
    const float th = 1.f - 2.f * __builtin_amdgcn_rcpf(1.f + e);
    return 0.5f * y * (1.f + th);
}
__device__ __forceinline__ void s5_wave_unit(Frame& F, const Args& A, int b, int g, LAS unsigned char* wl) {
    const int lane = F.lane, fr = lane & 15, fq = lane >> 4;
    LAS float* BUl = (LAS float*)wl;
    LAS bf16* Xl = (LAS bf16*)(wl + 16 * 132 * 4);
    bf16x8 bbA[8], crA[4];
#pragma unroll
    for (int n = 0; n < 8; ++n) bbA[n] = __builtin_bit_cast(bf16x8, *(const GAS v4u*)(F.ws + WS_BBF + ((size_t)(g * 8 + n) * 64 + lane) * 16));
#pragma unroll
    for (int k = 0; k < 4; ++k) crA[k] = __builtin_bit_cast(bf16x8, *(const GAS v4u*)(F.ws + WS_CRF + ((size_t)(g * 4 + k) * 64 + lane) * 16));
    const f32x2 ab = *(const GAS f32x2*)(F.ws + WS_AB + ((size_t)g * 64 + lane) * 8);
    const float ar = ab.x, ai = ab.y;
    float dsk[4];
#pragma unroll
    for (int r = 0; r < 4; ++r) dsk[r] = A.in[I_S5_D][16 * g + 4 * fq + r];
    float xr = 0.f, xi = 0.f;
    const bf16* up = (const bf16*)(F.ws + WS_H) + (size_t)(b * SEQ) * N0 + 16 * g;
    bf16* yp = (bf16*)(F.ws + WS_YG) + (size_t)(b * SEQ) * S5W + 16 * g;
    v4u ub = (v4u){0u, 0u, 0u, 0u};
    if (fq < 2) ub = *(const GAS v4u*)(up + (size_t)fr * N0 + 8 * fq);
    for (int blk = 0; blk < SEQ / 16; ++blk) {
        const int tok0 = 16 * blk;
        const bf16x8 ubf = __builtin_bit_cast(bf16x8, ub);
        const v2u u4 = *(const GAS v2u*)(up + (size_t)(tok0 + fr) * N0 + 4 * fq);
        v4u ubn = (v4u){0u, 0u, 0u, 0u};
        if (fq < 2 && blk + 1 < SEQ / 16) ubn = *(const GAS v4u*)(up + (size_t)(tok0 + 16 + fr) * N0 + 8 * fq);
#pragma unroll
        for (int n = 0; n < 8; ++n) { const f32x4 d = mfma16(bbA[n], ubf, (f32x4){0.f, 0.f, 0.f, 0.f}); *(LAS f32x4*)(BUl + fr * 132 + 16 * n + 4 * fq) = d; }
        CFENCE();
#pragma unroll
        for (int t = 0; t < 16; ++t) {
            const float bre = BUl[t * 132 + lane], bim = BUl[t * 132 + 64 + lane];
            const float nxr = ar * xr - ai * xi + bre, nxi = ar * xi + ai * xr + bim; xr = nxr; xi = nxi;
            Xl[t * 136 + lane] = (bf16)(pk2(xr, 0.f) & 0xffffu); Xl[t * 136 + 64 + lane] = (bf16)(pk2(xi, 0.f) & 0xffffu);
        }
        CFENCE();
        f32x4 acc = (f32x4){0.f, 0.f, 0.f, 0.f};
#pragma unroll
        for (int k = 0; k < 4; ++k) { const bf16x8 bx = *(const LAS bf16x8*)(Xl + fr * 136 + 32 * k + 8 * fq); acc = mfma16(crA[k], bx, acc); }
        CFENCE();
        const float u0 = bflo(u4.x), u1 = bfhi(u4.x), u2 = bflo(u4.y), u3 = bfhi(u4.y);
        const float y0 = gelu_tanh(acc[0] + dsk[0] * u0), y1 = gelu_tanh(acc[1] + dsk[1] * u1), y2 = gelu_tanh(acc[2] + dsk[2] * u2), y3 = gelu_tanh(acc[3] + dsk[3] * u3);
        v2u o; o.x = pk2(y0, y1); o.y = pk2(y2, y3);
        *(GAS v2u*)(yp + (size_t)(tok0 + fr) * S5W + 4 * fq) = o;
        ub = ubn;
    }
}

template <int MODE>
__device__ __forceinline__ void chunk_mixer_unit(Frame& F, const Args& A, int b, int h) {
    constexpr int NVT = MODE == 0 ? 2 : 1, DV = 128 * NVT;
    constexpr int LDH = MODE == 0 ? N0 : OD_IN;
    constexpr int QCOL = MODE == 0 ? 2048 : 0, KCOL = MODE == 0 ? 3072 : 4096, VCOL = MODE == 0 ? 4096 : 8192, GCOL = MODE == 0 ? 6144 : 12288, YCOL = MODE == 0 ? 2048 : 0;
    constexpr int VPT = MODE == 0 ? 4 : 2;
    LAS unsigned char* L = F.lds;
    LAS bf16* QD = (LAS bf16*)(L + 0);
    LAS bf16* KI = (LAS bf16*)(L + 17408);
    LAS bf16* KE = (LAS bf16*)(L + 34816);
    LAS bf16* SC = (LAS bf16*)(L + 53248);
    LAS float* DEC = (LAS float*)(L + 62464);
    LAS float* XCH = (LAS float*)(L + 62976);
    LAS float* PART = (LAS float*)(L + 67072);
    LAS bf16* VT = (LAS bf16*)(L + 69120);
    const int tid = F.tid, lane = F.lane, w = tid >> 6, cp = lane, fr = lane & 15, fq = lane >> 4, c0 = 2 * cp;
    const bf16* Hb = (const bf16*)(F.ws + WS_H) + (size_t)(b * SEQ) * LDH;
    bf16* Yb = (bf16*)(F.ws + WS_YCAT) + (size_t)(b * SEQ) * D + YCOL + h * DV;
    const bf16* hq = Hb + QCOL + h * 128 + c0;
    const bf16* hk = Hb + KCOL + h * 128 + c0;
    const bf16* hv = Hb + VCOL + h * DV + VPT * cp;
    const bf16* hg = Hb + GCOL + h * DV;
    float lb[2], ba[2];
    if constexpr (MODE == 1) {
#pragma unroll
        for (int e = 0; e < 2; ++e) { const float t0 = A.in[I_HG_LB][h * 128 + c0 + e], t1 = A.in[I_HG_LB][D + h * 128 + c0 + e]; lb[e] = 1.f / (1.f + __expf(t0 - t1)); }
    } else {
#pragma unroll
        for (int e = 0; e < 2; ++e) ba[e] = A.in[I_GLA_B_ALPHA][h * 128 + c0 + e];
    }
    float gn[NVT][4];
#pragma unroll
    for (int vt = 0; vt < NVT; ++vt)
#pragma unroll
        for (int r = 0; r < 4; ++r) gn[vt][r] = (MODE == 0 ? A.in[I_GLA_NORM_G] : A.in[I_HG_NORM_G])[16 * (NVT * w + vt) + 4 * fq + r];
    f32x4 Sacc[NVT][8];
#pragma unroll
    for (int vt = 0; vt < NVT; ++vt)
#pragma unroll
        for (int dt = 0; dt < 8; ++dt) Sacc[vt][dt] = (f32x4){0.f, 0.f, 0.f, 0.f};
    unsigned q2[8], k2[8]; v2u v4[8]; f32x2 dcv[8];
    const float* gdp = (const float*)(F.ws + WS_GDEC) + (size_t)(b * SEQ + 8 * w) * 1024 + h * 128 + c0;
#define MIX_LOAD(c) do { _Pragma("unroll") for (int j = 0; j < 8; ++j) { const size_t ro = (size_t)(64 * (c) + 8 * w + j) * LDH; \
        q2[j] = *(const GAS unsigned*)(hq + ro); k2[j] = *(const GAS unsigned*)(hk + ro); \
        if (MODE == 0) dcv[j] = *(const GAS f32x2*)(gdp + (size_t)(64 * (c) + j) * 1024); \
        if (MODE == 0) v4[j] = *(const GAS v2u*)(hv + ro); else { v4[j].x = *(const GAS unsigned*)(hv + ro); v4[j].y = 0u; } } } while (0)
    MIX_LOAD(0);
    for (int c = 0; c < SEQ / 64; ++c) {
        float kk[8][2], cs[8][2];
        unsigned vtw[VPT][4];
        if constexpr (MODE == 1) {
            float vv[8][2];
#pragma unroll
            for (int j = 0; j < 8; ++j)
#pragma unroll
                for (int e = 0; e < 2; ++e) {
                    const float fl = e ? bfhi(k2[j]) : bflo(k2[j]);
                    const float tt = __expf(-fl), sg = __builtin_amdgcn_rcpf(1.f + tt);
                    const float f = lb[e] + (1.f - lb[e]) * sg;
                    cs[j][e] = f; kk[j][e] = (1.f - lb[e]) * (tt * sg);
                    const float iv = e ? bfhi(v4[j].x) : bflo(v4[j].x);
                    vv[j][e] = iv * __builtin_amdgcn_rcpf(1.f + __expf(-iv));
                }
#pragma unroll
            for (int jp = 0; jp < 4; ++jp) { vtw[0][jp] = pk2(vv[2 * jp][0], vv[2 * jp + 1][0]); vtw[1][jp] = pk2(vv[2 * jp][1], vv[2 * jp + 1][1]); }
        } else {
#pragma unroll
            for (int j = 0; j < 8; ++j) { cs[j][0] = dcv[j].x; cs[j][1] = dcv[j].y; }
        }
#pragma unroll
        for (int j = 1; j < 8; ++j) { cs[j][0] *= cs[j - 1][0]; cs[j][1] *= cs[j - 1][1]; }
        *(LAS f32x2*)(XCH + w * 128 + c0) = (f32x2){cs[7][0], cs[7][1]};
        __syncthreads();
        float off[2] = {1.f, 1.f}, bend[2] = {1.f, 1.f};
#pragma unroll
        for (int ww = 0; ww < 8; ++ww) { const f32x2 t2 = *(const LAS f32x2*)(XCH + ww * 128 + c0); if (ww < w) { off[0] *= t2.x; off[1] *= t2.y; } bend[0] *= t2.x; bend[1] *= t2.y; }
        {
            unsigned ke[2][4];
#pragma unroll
            for (int j = 0; j < 8; j += 2) {
                float qd[2][2], ki[2][2], kev[2][2];
#pragma unroll
                for (int jj = 0; jj < 2; ++jj)
#pragma unroll
                    for (int e = 0; e < 2; ++e) { const float pq = cs[j + jj][e] * off[e];
                        const float qv = (e ? bfhi(q2[j + jj]) : bflo(q2[j + jj])) * (MODE == 0 ? 0.08838834764831845f : 1.f);
                        const float kv_ = (MODE == 1) ? kk[j + jj][e] : (e ? bfhi(k2[j + jj]) : bflo(k2[j + jj]));
                        qd[jj][e] = qv * pq; ki[jj][e] = kv_ * __builtin_amdgcn_rcpf(pq); kev[jj][e] = ki[jj][e] * bend[e]; }
                *(LAS unsigned*)(QD + (8 * w + j) * 136 + c0) = pk2(qd[0][0], qd[0][1]); *(LAS unsigned*)(QD + (8 * w + j + 1) * 136 + c0) = pk2(qd[1][0], qd[1][1]);
                *(LAS unsigned*)(KI + (8 * w + j) * 136 + c0) = pk2(ki[0][0], ki[0][1]); *(LAS unsigned*)(KI + (8 * w + j + 1) * 136 + c0) = pk2(ki[1][0], ki[1][1]);
                ke[0][j >> 1] = pk2(kev[0][0], kev[1][0]); ke[1][j >> 1] = pk2(kev[0][1], kev[1][1]);
            }
#pragma unroll
            for (int e = 0; e < 2; ++e) *(LAS v4u*)(KE + (c0 + e) * 72 + 8 * w) = (v4u){ke[e][0], ke[e][1], ke[e][2], ke[e][3]};
            if constexpr (MODE == 0) {
#pragma unroll
                for (int jp = 0; jp < 4; ++jp) { const int j = 2 * jp;
                    vtw[0][jp] = (v4[j].x & 0xffffu) | (v4[j + 1].x << 16); vtw[1][jp] = (v4[j].x >> 16) | (v4[j + 1].x & 0xffff0000u);
                    vtw[VPT - 2][jp] = (v4[j].y & 0xffffu) | (v4[j + 1].y << 16); vtw[VPT - 1][jp] = (v4[j].y >> 16) | (v4[j + 1].y & 0xffff0000u); }
            }
#pragma unroll
            for (int e = 0; e < VPT; ++e) *(LAS v4u*)(VT + (VPT * cp + e) * 72 + 8 * w) = (v4u){vtw[e][0], vtw[e][1], vtw[e][2], vtw[e][3]};
            if (w == 0) *(LAS f32x2*)(DEC + c0) = (f32x2){bend[0], bend[1]};
        }
        __syncthreads();
        if (c + 1 < SEQ / 64) MIX_LOAD(c + 1);
        {
            const int tt = w >> 1;
#pragma unroll
            for (int si = 0; si < 2; ++si) {
                const int st = 2 * (w & 1) + si;
                v2u o = (v2u){0u, 0u};
                if (st <= tt) {
                    f32x4 a = (f32x4){0.f, 0.f, 0.f, 0.f};
#pragma unroll
                    for (int ks = 0; ks < 4; ++ks) { const bf16x8 fa = *(const LAS bf16x8*)(KI + (16 * st + fr) * 136 + 32 * ks + 8 * fq); const bf16x8 fb = *(const LAS bf16x8*)(QD + (16 * tt + fr) * 136 + 32 * ks + 8 * fq); a = mfma16(fa, fb, a); }
                    const int tcol = 16 * tt + fr, s0 = 16 * st + 4 * fq;
                    const float m0 = (s0 + 0 <= tcol) ? a[0] : 0.f, m1 = (s0 + 1 <= tcol) ? a[1] : 0.f, m2 = (s0 + 2 <= tcol) ? a[2] : 0.f, m3 = (s0 + 3 <= tcol) ? a[3] : 0.f;
                    o.x = pk2(m0, m1); o.y = pk2(m2, m3);
                }
                *(LAS v2u*)(SC + (16 * tt + fr) * 72 + 16 * st + 4 * fq) = o;
            }
        }
        __syncthreads();
        v2u g4r[NVT][4];
#pragma unroll
        for (int tt = 0; tt < 4; ++tt)
#pragma unroll
            for (int vt = 0; vt < NVT; ++vt) g4r[vt][tt] = *(const GAS v2u*)(hg + (size_t)(64 * c + 16 * tt + fr) * LDH + 16 * (NVT * w + vt) + 4 * fq);
        f32x4 oacc[NVT][4];
#pragma unroll
        for (int vt = 0; vt < NVT; ++vt) {
            const int vrow = 16 * (NVT * w + vt) + fr;
            bf16x8 sA[4];
#pragma unroll
            for (int j = 0; j < 4; ++j) { v4u t4; t4.x = pk2(Sacc[vt][2 * j][0], Sacc[vt][2 * j][1]); t4.y = pk2(Sacc[vt][2 * j][2], Sacc[vt][2 * j][3]); t4.z = pk2(Sacc[vt][2 * j + 1][0], Sacc[vt][2 * j + 1][1]); t4.w = pk2(Sacc[vt][2 * j + 1][2], Sacc[vt][2 * j + 1][3]); sA[j] = __builtin_bit_cast(bf16x8, t4); }
            bf16x8 vA[2];
#pragma unroll
            for (int ks = 0; ks < 2; ++ks) vA[ks] = *(const LAS bf16x8*)(VT + vrow * 72 + 32 * ks + 8 * fq);
#pragma unroll
            for (int tt = 0; tt < 4; ++tt) {
                f32x4 a = (f32x4){0.f, 0.f, 0.f, 0.f};
#pragma unroll
                for (int ks = 0; ks < 2; ++ks) { const bf16x8 fb = *(const LAS bf16x8*)(SC + (16 * tt + fr) * 72 + 32 * ks + 8 * fq); a = mfma16(vA[ks], fb, a); }
#pragma unroll
                for (int j = 0; j < 4; ++j) { const v2u b0 = *(const LAS v2u*)(QD + (16 * tt + fr) * 136 + 32 * j + 4 * fq), b1 = *(const LAS v2u*)(QD + (16 * tt + fr) * 136 + 32 * j + 16 + 4 * fq);
                    a = mfma16(sA[j], __builtin_bit_cast(bf16x8, (v4u){b0.x, b0.y, b1.x, b1.y}), a); }
                oacc[vt][tt] = a;
            }
#pragma unroll
            for (int dt = 0; dt < 8; ++dt) {
                const f32x4 dc = *(const LAS f32x4*)(DEC + 16 * dt + 4 * fq);
                f32x4 a = Sacc[vt][dt] * dc;
#pragma unroll
                for (int ks = 0; ks < 2; ++ks) { const bf16x8 fa = *(const LAS bf16x8*)(KE + (16 * dt + fr) * 72 + 32 * ks + 8 * fq); a = mfma16(fa, vA[ks], a); }
                Sacc[vt][dt] = a;
            }
        }
#pragma unroll
        for (int tt = 0; tt < 4; ++tt) { float s = 0.f;
#pragma unroll
            for (int vt = 0; vt < NVT; ++vt) s += (oacc[vt][tt][0] * oacc[vt][tt][0] + oacc[vt][tt][1] * oacc[vt][tt][1]) + (oacc[vt][tt][2] * oacc[vt][tt][2] + oacc[vt][tt][3] * oacc[vt][tt][3]);
            s += __shfl_xor(s, 16); s += __shfl_xor(s, 32);
            if (fq == 0) PART[w * 64 + 16 * tt + fr] = s; }
        __syncthreads();
#pragma unroll
        for (int tt = 0; tt < 4; ++tt) {
            float tot = 0.f;
#pragma unroll
            for (int ww = 0; ww < 8; ++ww) tot += PART[ww * 64 + 16 * tt + fr];
            const float rinv = __builtin_amdgcn_rsqf(tot * (1.f / DV) + NORM_EPS);
            const size_t tok = (size_t)(64 * c + 16 * tt + fr);
#pragma unroll
            for (int vt = 0; vt < NVT; ++vt) {
                const int col = 16 * (NVT * w + vt) + 4 * fq;
                const v2u g4 = g4r[vt][tt];
                const float g0 = bflo(g4.x), g1 = bfhi(g4.x), g2 = bflo(g4.y), g3 = bfhi(g4.y);
                const float y0 = oacc[vt][tt][0] * rinv * gn[vt][0] * (g0 * pg8::sigmoidf_(g0)), y1 = oacc[vt][tt][1] * rinv * gn[vt][1] * (g1 * pg8::sigmoidf_(g1));
                const float y2 = oacc[vt][tt][2] * rinv * gn[vt][2] * (g2 * pg8::sigmoidf_(g2)), y3 = oacc[vt][tt][3] * rinv * gn[vt][3] * (g3 * pg8::sigmoidf_(g3));
                v2u o; o.x = pk2(y0, y1); o.y = pk2(y2, y3);
                *(GAS v2u*)(Yb + tok * D + col) = o;
            }
        }
    }
#undef MIX_LOAD
    __syncthreads();
}

__global__ void __launch_bounds__(NWAVES * 64, 2) fwd_kernel(Args args) {
    extern __shared__ __attribute__((aligned(16))) unsigned char lds[];
    Frame F;
    F.lds = (LAS unsigned char*)lds;
    F.MISC = (volatile LAS unsigned*)(F.lds + MISC_OFF);
    F.tid = threadIdx.x; F.lane = F.tid & 63; F.wave = __builtin_amdgcn_readfirstlane(F.tid >> 6);
    F.G = gridDim.x; { const int bx = blockIdx.x; F.vcu = (F.G % 8 == 0) ? (bx % 8) * (F.G / 8) + bx / 8 : bx; }
    F.out = args.out; F.ws = args.ws;
    F.ctl = (gu32*)(args.ws + WS_CTL);
    for (int u = F.tid; u < (LDS_BYTES - LDSCTL_OFF) / 4; u += NWAVES * 64) ((LAS unsigned*)(F.lds + LDSCTL_OFF))[u] = 0u;
    __syncthreads();
    XcdBarrier bar; bar.bar = (unsigned*)(F.ctl + CW_BAR); bar.x = 0; bar.st = nullptr;
    if (N_LAUNCHES == 1) bar = xcd_barrier_post((unsigned*)(F.ctl + CW_BAR), F.MISC + 8);
#define GRID_BAR() do { if (N_LAUNCHES == 1) xcd_barrier(bar); } while (0)
    bool loc_ok = false;
    if (N_LAUNCHES == 1 && F.tid == 0) {
        const unsigned me = xb_xcc_id() + 1u, old = atomicCAS((unsigned*)(F.ctl + 8 + (blockIdx.x & 7)), 0u, me);
        if ((old != 0u && old != me) || F.G != 256) atomicAdd((unsigned*)(F.ctl + 2), 1u);
    }
#define XCD_BAR() do { if (N_LAUNCHES == 1) xcd_barrier(bar, loc_ok); } while (0)
    const int lo = args.ph_lo, hi = args.ph_hi;
#ifdef ONLY_PHASE
#define IN(k) ((k) == ONLY_PHASE && lo <= (k) && (k) < hi)
#else
#define IN(k) (lo <= (k) && (k) < hi)
#endif
#define BOTH(k) (IN(k) && IN((k) + 1))
    unsigned char* ws = args.ws;
    bf16* XB = (bf16*)(ws + WS_XB); bf16* HB = (bf16*)(ws + WS_H); bf16* YG = (bf16*)(ws + WS_YG); bf16* YC = (bf16*)(ws + WS_YCAT);
    bf16* Z = (bf16*)(ws + WS_Z); float* ST = (float*)(ws + WS_STATS);
    const int bid = blockIdx.x;

    if (IN(0)) { p0a_phase(F, args, true, F.vcu * NWAVES + F.wave, F.G * NWAVES, 0, NITEMS_EARLY); if (BOTH(0)) GRID_BAR(); }
    if (N_LAUNCHES == 1) loc_ok = (xb_ld((unsigned*)(F.ctl + 2)) == 0u) && F.MISC[8] == 32u && F.MISC[9] == 8u;
    if (IN(1)) { p0b_phase(F, args); if (BOTH(1)) XCD_BAR(); }
    if (IN(2)) {
        pg8::Gemm g{XB, (const bf16*)(ws + WS_W_IN0), M, N0, D}; pg8::StaticOrder S; S.init(M, N0, F.G, bid);
        pg8::EpiBf16 E{HB, N0};
        pg8::gemm_phase<pg8::EpiBf16, pg8::StaticOrder, PG8_ALIGN, PG8_SP2>(F.lds + RING_OFF, g, S, E);
        if (BOTH(2)) XCD_BAR();
    }
    if (IN(3)) {
        if (bid < 64) chunk_mixer_unit<0>(F, args, bid & 7, bid >> 3);
        else if (bid < 192) { s5_wave_unit(F, args, bid & 7, ((bid - 64) >> 3) * 8 + F.wave, F.lds + RING_OFF + F.wave * 12800);
            __syncthreads();
            p0a_phase(F, args, false, (bid - 64) * NWAVES + F.wave, 128 * NWAVES, NITEMS_EARLY, NITEMS_P3B); }
        else p0a_phase(F, args, false, (bid - 192) * NWAVES + F.wave, (F.G - 192) * NWAVES, NITEMS_P3B, NITEMS_P7);
        if (BOTH(3)) GRID_BAR();
    }
    if (IN(4)) {
        pg8::Gemm g{YG, (const bf16*)(ws + WS_W_GLU), M, S5W, S5W}; pg8::StaticOrder S; S.init(M, S5W, F.G, bid);
        pg8::EpiGlu E{YG, S5W, YC, D};
        pg8::gemm_phase<pg8::EpiGlu, pg8::StaticOrder, PG8_ALIGN, PG8_SP2>(F.lds + RING_OFF, g, S, E);
        if (BOTH(4)) XCD_BAR();
    }
    if (IN(5)) {
        pg8::Gemm g{YC, (const bf16*)(ws + WS_W_OUT0), M, D, D}; pg8::StaticOrder S; S.init(M, D, F.G, bid);
        pg8::EpiResT<false> E{args.in[I_X], Z, D, DN_ALPHA, nullptr, nullptr, nullptr};
        pg8::gemm_phase<pg8::EpiResT<false>, pg8::StaticOrder, PG8_ALIGN, PG8_SP2>(F.lds + RING_OFF, g, S, E);
        if (BOTH(5)) XCD_BAR();
    }
    if (IN(6)) { ln_phase(F, Z, args.in[I_LN_MIX_G], args.in[I_LN_MIX_B], nullptr, XB, ST); if (BOTH(6)) XCD_BAR(); }
    if (IN(7)) {
        pg8::Gemm g{XB, (const bf16*)(ws + WS_W_GU0), M, NGU, D}; pg8::StaticOrder S; S.init(M, NGU, F.G, bid);
        pg8::EpiSwiGlu E{HB, FF, HSLAB_EL};
        pg8::gemm_phase<pg8::EpiSwiGlu, pg8::StaticOrder, PG8_ALIGN, PG8_SP2>(F.lds + RING_OFF, g, S, E);
        if (bid >= 128) p0a_phase(F, args, false, (bid - 128) * NWAVES + F.wave, (F.G - 128) * NWAVES, NITEMS_P7, NITEMS_P14);
        if (BOTH(7)) XCD_BAR();
    }
    if (IN(8)) {
        pg8::Gemm g{HB, (const bf16*)(ws + WS_W_DN0), M, D, FF, HSLAB_EL * 2}; pg8::StaticOrder S; S.init(M, D, F.G, bid);
        pg8::EpiResT<true> E{nullptr, Z, D, DN_ALPHA, ST, args.in[I_LN_MIX_G], args.in[I_LN_MIX_B]};
        pg8::gemm_phase<pg8::EpiResT<true>, pg8::StaticOrder, PG8_ALIGN, PG8_SP2>(F.lds + RING_OFF, g, S, E);
        if (BOTH(8)) XCD_BAR();
    }
    if (IN(9)) { ln_phase(F, Z, args.in[I_LN_FFN_G], args.in[I_LN_FFN_B], nullptr, XB, ST); if (BOTH(9)) XCD_BAR(); }
    if (IN(10)) {
        pg8::Gemm g{XB, (const bf16*)(ws + WS_W_IN1), M, OD_IN, D}; pg8::StaticOrder S; S.init(M, OD_IN, F.G, bid);
        pg8::EpiBf16 E{HB, OD_IN};
        pg8::gemm_phase<pg8::EpiBf16, pg8::StaticOrder, PG8_ALIGN, PG8_SP2>(F.lds + RING_OFF, g, S, E);
        if (BOTH(10)) XCD_BAR();
    }
    if (IN(11)) { for (int u = bid; u < 256; u += F.G) chunk_mixer_unit<1>(F, args, u & 7, u >> 3); if (BOTH(11)) XCD_BAR(); }
    if (IN(12)) {
        pg8::Gemm g{YC, (const bf16*)(ws + WS_W_OUT1), M, D, D}; pg8::StaticOrder S; S.init(M, D, F.G, bid);
        pg8::EpiResT<true> E{nullptr, Z, D, DN_ALPHA, ST, args.in[I_LN_FFN_G], args.in[I_LN_FFN_B]};
        pg8::gemm_phase<pg8::EpiResT<true>, pg8::StaticOrder, PG8_ALIGN, PG8_SP2>(F.lds + RING_OFF, g, S, E);
        if (BOTH(12)) XCD_BAR();
    }
    if (IN(13)) { ln_phase(F, Z, args.in[I_LN_MIX_G] + D, args.in[I_LN_MIX_B] + D, nullptr, XB, ST); if (BOTH(13)) GRID_BAR(); }
    if (IN(14)) {
        pg8::Gemm g{XB, (const bf16*)(ws + WS_W_GU1), M, NGU, D}; pg8::StaticOrder S; S.init(M, NGU, F.G, bid);
        pg8::EpiSwiGlu E{HB, FF, HSLAB_EL};
        pg8::gemm_phase<pg8::EpiSwiGlu, pg8::StaticOrder, PG8_ALIGN, PG8_SP2>(F.lds + RING_OFF, g, S, E);
        if (bid >= 128) p0a_phase(F, args, false, (bid - 128) * NWAVES + F.wave, (F.G - 128) * NWAVES, NITEMS_P14, NITEMS);
        if (BOTH(14)) GRID_BAR();
    }
    if (IN(15)) {
        pg8::Gemm g{HB, (const bf16*)(ws + WS_W_DN1), M, D, FF, HSLAB_EL * 2}; pg8::StaticOrder S; S.init(M, D, F.G, bid);
        pg8::EpiResT<true> E{nullptr, Z, D, DN_ALPHA, ST, args.in[I_LN_MIX_G] + D, args.in[I_LN_MIX_B] + D};
        pg8::gemm_phase<pg8::EpiResT<true>, pg8::StaticOrder, PG8_ALIGN, PG8_SP2>(F.lds + RING_OFF, g, S, E);
        if (BOTH(15)) XCD_BAR();
    }
    if (IN(16)) { ln_phase(F, Z, args.in[I_LN_FFN_G] + D, args.in[I_LN_FFN_B] + D, F.out, nullptr, nullptr); }
#undef IN
#undef BOTH
}

extern "C" void kernel_launch(void* const* d_in, const int* in_sizes, int n_in, void* d_out, int out_size, void* d_ws, size_t ws_size, hipStream_t stream) {
    static int grid = 0;
    if (grid == 0) {
        if (n_in != 26 || in_sizes[0] != M * D || out_size != M * D || ws_size < WS_END) { fprintf(stderr, "kernel_launch: unexpected problem: n_in %d in0 %d out %d ws %zu (need %zu)\n", n_in, n_in > 0 ? in_sizes[0] : -1, out_size, ws_size, (size_t)WS_END); grid = -1; return; }
        if (hipFuncSetAttribute((const void*)fwd_kernel, hipFuncAttributeMaxDynamicSharedMemorySize, LDS_BYTES) != hipSuccess) { fprintf(stderr, "kernel_launch: hipFuncSetAttribute failed\n"); grid = -1; return; }
        int per_cu = 0;
        if (hipOccupancyMaxActiveBlocksPerMultiprocessor(&per_cu, (const void*)fwd_kernel, NWAVES * 64, LDS_BYTES) != hipSuccess || per_cu < 1)
            fprintf(stderr, "kernel_launch: note: occupancy query reports %d workgroups per CU\n", per_cu);
        (void)hipGetLastError();
        grid = 256;
    }
    if (grid < 0) return;
    if (hipMemsetAsync((char*)d_ws + WS_CTL, 0, CTL_ZERO_BYTES, stream) != hipSuccess) { fprintf(stderr, "kernel_launch: memset failed\n"); return; }
    Args a{};
    for (int i = 0; i < 26; ++i) a.in[i] = (const float*)d_in[i];
    a.out = (float*)d_out; a.ws = (unsigned char*)d_ws;
#ifndef PROBE_REPS
#define PROBE_REPS {1,1,1,1,1,1,1,1,1,1,1,1,1,1,1,1,1}
#endif
    static const int probe_reps[NPH] = PROBE_REPS;
    for (int li = 0; li < N_LAUNCHES; ++li) for (int rep = 0; rep < (N_LAUNCHES == 1 ? 1 : probe_reps[li]); ++rep) {
        a.ph_lo = (N_LAUNCHES == 1) ? 0 : li; a.ph_hi = (N_LAUNCHES == 1) ? NPH : li + 1; a.li = li; a.pad = 0;
        hipLaunchKernelGGL(fwd_kernel, dim3(grid), dim3(NWAVES * 64), LDS_BYTES, stream, a);
        const hipError_t le = hipPeekAtLastError();
        if (le != hipSuccess) { fprintf(stderr, "kernel_launch: launch %d failed: %s\n", li, hipGetErrorName(le)); break; }
    }
}
```

```cpp
#include <hip/hip_runtime.h>
#include <cstdio>
#include <cstdint>

#ifndef MK_N_LAUNCHES
#define MK_N_LAUNCHES 1
#endif

namespace pg8 {
#define PG8_LAS __attribute__((address_space(3)))
typedef unsigned short bf16_t;
typedef short bf16x8 __attribute__((ext_vector_type(8)));
typedef float f32x4 __attribute__((ext_vector_type(4)));
typedef unsigned u32x4 __attribute__((ext_vector_type(4)));
constexpr int BM = 256, BK = 64, HALF = 128, HTB = HALF * BK * 2, STAGE_BYTES = 8 * HTB, NXCD = 8, WGM = 8;

__host__ __device__ __forceinline__ int lds_byte(int r, int c) { const int st = (r >> 4) * 2 + (c >> 5), rr = r & 15, cc = c & 31, ob = rr * 64 + cc * 2; return st * 1024 + (ob ^ (((ob >> 9) & 1) << 5)); }
__host__ __device__ __forceinline__ void stage_rc(int b, int& R, int& C) { const int st = b / 1024, sb = b % 1024, swz = sb ^ (((sb >> 9) & 1) << 5); R = (st >> 1) * 16 + swz / 64; C = (st & 1) * 32 + (swz % 64) / 2; }
__host__ __device__ __forceinline__ int perm32(int rho) { const int n = rho >> 4, i = rho & 15; return 8 * (i >> 2) + 4 * n + (i & 3); }

struct Unit { int pm, pn; };
struct Gemm { const bf16_t* A; const bf16_t* Bt; int M, N, K; size_t bsA; };

struct StaticOrder {
    int nM, nN, nwg, G, c;
    __host__ __device__ void init(int M, int N, int G_, int c_) { nM = M / BM; nN = N / BM; nwg = nM * nN; G = G_; c = c_; }
    __host__ __device__ bool next(int i, Unit& u) const {
        const long L = (long)i * G + c; if (L >= nwg) return false;
        int wgid = (int)L; { const int q = nwg / NXCD, r = nwg % NXCD, xcd = wgid % NXCD, off = wgid / NXCD; wgid = (xcd < r ? xcd * (q + 1) : r * (q + 1) + (xcd - r) * q) + off; }
        const int nig = WGM * nN, gid = wgid / nig, fm = gid * WGM, gsz = (nM - fm) < WGM ? (nM - fm) : WGM;
        u.pm = fm + ((wgid % nig) % gsz); u.pn = (wgid % nig) / gsz; return true;
    }
    __device__ __forceinline__ void a_ready(const Unit&) const {}
    __device__ __forceinline__ void done(const Unit&) const {}
};

__device__ __forceinline__ unsigned cvt_pk_bf16(float lo, float hi) { unsigned r; asm volatile("v_cvt_pk_bf16_f32 %0, %1, %2" : "=v"(r) : "v"(lo), "v"(hi)); return r; }
__device__ __forceinline__ float bflo(unsigned x) { return __uint_as_float(x << 16); }
__device__ __forceinline__ float bfhi(unsigned x) { return __uint_as_float(x & 0xffff0000u); }
typedef _Float16 zh2 __attribute__((ext_vector_type(2)));
typedef float zf2 __attribute__((ext_vector_type(2)));
__device__ __forceinline__ unsigned pk_h2(float lo, float hi) { const zf2 f = {__builtin_fminf(__builtin_fmaxf(lo, -65504.f), 65504.f), __builtin_fminf(__builtin_fmaxf(hi, -65504.f), 65504.f)}; return __builtin_bit_cast(unsigned, __builtin_convertvector(f, zh2)); }
__device__ __forceinline__ float hflo(unsigned x) { return (float)__builtin_bit_cast(zh2, x).x; }
__device__ __forceinline__ float hfhi(unsigned x) { return (float)__builtin_bit_cast(zh2, x).y; }
__device__ __forceinline__ float sigmoidf_(float x) { return __builtin_amdgcn_rcpf(1.0f + __expf(-x)); }

struct EpiBf16 {
    static constexpr bool PERM = true, AFTER_DRAIN = false;
    bf16_t* O; int ldc;
    __device__ __forceinline__ void operator()(const f32x4 (&acc)[2][2][4][2], const Unit& u, int wr, int wc, int fr, int fq) const {
        const int row0 = u.pm * BM + wr * 64 + fr, col0 = u.pn * BM + wc * 32 + 8 * fq;
#pragma unroll
        for (int ai = 0; ai < 2; ++ai)
#pragma unroll
            for (int m = 0; m < 4; ++m) { bf16_t* rowp = O + (size_t)(row0 + ai * HALF + m * 16) * ldc + col0;
#pragma unroll
                for (int bj = 0; bj < 2; ++bj) { const f32x4 v0 = acc[ai][bj][m][0], v1 = acc[ai][bj][m][1];
                    u32x4 w; w.x = cvt_pk_bf16(v0[0], v0[1]); w.y = cvt_pk_bf16(v0[2], v0[3]); w.z = cvt_pk_bf16(v1[0], v1[1]); w.w = cvt_pk_bf16(v1[2], v1[3]);
                    *(u32x4*)(rowp + bj * HALF) = w; } }
    }
};
struct EpiGlu {
    static constexpr bool PERM = true, AFTER_DRAIN = false;
    const bf16_t* A; int lda; bf16_t* O; int ldc;
    __device__ __forceinline__ void operator()(const f32x4 (&acc)[2][2][4][2], const Unit& u, int wr, int wc, int fr, int fq) const {
        const int row0 = u.pm * BM + wr * 64 + fr, col0 = u.pn * BM + wc * 32 + 8 * fq;
#pragma unroll
        for (int ai = 0; ai < 2; ++ai) {
            u32x4 yv[4][2];
#pragma unroll
            for (int m = 0; m < 4; ++m)
#pragma unroll
                for (int bj = 0; bj < 2; ++bj) yv[m][bj] = *(const u32x4*)(A + (size_t)(row0 + ai * HALF + m * 16) * lda + col0 + bj * HALF);
#pragma unroll
            for (int m = 0; m < 4; ++m) { const size_t r = (size_t)(row0 + ai * HALF + m * 16);
#pragma unroll
                for (int bj = 0; bj < 2; ++bj) { const f32x4 v0 = acc[ai][bj][m][0], v1 = acc[ai][bj][m][1];
                    const u32x4 y = yv[m][bj];
                    u32x4 w;
                    w.x = cvt_pk_bf16(bflo(y.x) * sigmoidf_(v0[0]), bfhi(y.x) * sigmoidf_(v0[1]));
                    w.y = cvt_pk_bf16(bflo(y.y) * sigmoidf_(v0[2]), bfhi(y.y) * sigmoidf_(v0[3]));
                    w.z = cvt_pk_bf16(bflo(y.z) * sigmoidf_(v1[0]), bfhi(y.z) * sigmoidf_(v1[1]));
                    w.w = cvt_pk_bf16(bflo(y.w) * sigmoidf_(v1[2]), bfhi(y.w) * sigmoidf_(v1[3]));
                    *(u32x4*)(O + r * ldc + col0 + bj * HALF) = w; } }
            asm volatile("" ::: "memory"); }
    }
};
template <bool LNRES> struct EpiResT {
    static constexpr bool PERM = false, AFTER_DRAIN = false;
    const float* res; bf16_t* Z; int ldc; float alpha; const float* stats; const float* gam; const float* bet;
    __device__ __forceinline__ void operator()(const f32x4 (&acc)[2][2][4][2], const Unit& u, int wr, int wc, int fr, int fq) const {
        const int row0 = u.pm * BM + wr * 64 + fr, col0 = u.pn * BM + wc * 32 + 4 * fq;
        f32x4 gv[2][2], bv[2][2];
        if constexpr (LNRES) {
#pragma unroll
            for (int bj = 0; bj < 2; ++bj)
#pragma unroll
                for (int n = 0; n < 2; ++n) { gv[bj][n] = *(const f32x4*)(gam + col0 + bj * HALF + n * 16); bv[bj][n] = *(const f32x4*)(bet + col0 + bj * HALF + n * 16); }
        }
        if constexpr (LNRES) {
#pragma unroll
            for (int ai = 0; ai < 2; ++ai) {
                unsigned long long zr[4][2][2]; zf2 stv[4];
#pragma unroll
                for (int m = 0; m < 4; ++m) { const int row = row0 + ai * HALF + m * 16; const size_t off = (size_t)row * ldc + col0;
                    stv[m] = *(const zf2*)(stats + 2 * row);
#pragma unroll
                    for (int bj = 0; bj < 2; ++bj)
#pragma unroll
                        for (int n = 0; n < 2; ++n) zr[m][bj][n] = *(const unsigned long long*)(Z + off + bj * HALF + n * 16); }
                asm volatile("" ::: "memory");
#pragma unroll
                for (int m = 0; m < 4; ++m) { const size_t off = (size_t)(row0 + ai * HALF + m * 16) * ldc + col0; const float mu = stv[m].x, rsd = stv[m].y;
#pragma unroll
                    for (int bj = 0; bj < 2; ++bj)
#pragma unroll
                        for (int n = 0; n < 2; ++n) { const unsigned lo = (unsigned)zr[m][bj][n], hi = (unsigned)(zr[m][bj][n] >> 32);
                            f32x4 r = (f32x4){hflo(lo), hfhi(lo), hflo(hi), hfhi(hi)};
                            r = (r - mu) * rsd * gv[bj][n] + bv[bj][n];
                            const f32x4 zn = r * alpha + acc[ai][bj][m][n];
                            *(unsigned long long*)(Z + off + bj * HALF + n * 16) = ((unsigned long long)pk_h2(zn[2], zn[3]) << 32) | pk_h2(zn[0], zn[1]); } }
                asm volatile("" ::: "memory"); }
        } else {
#pragma unroll
        for (int ai = 0; ai < 2; ++ai)
#pragma unroll
            for (int mp = 0; mp < 4; mp += 2) {
                f32x4 rs[2][2][2];
#pragma unroll
                for (int mm = 0; mm < 2; ++mm) { const size_t off = (size_t)(row0 + ai * HALF + (mp + mm) * 16) * ldc + col0;
#pragma unroll
                    for (int bj = 0; bj < 2; ++bj)
#pragma unroll
                        for (int n = 0; n < 2; ++n) rs[mm][bj][n] = *(const f32x4*)(res + off + bj * HALF + n * 16); }
#pragma unroll
                for (int mm = 0; mm < 2; ++mm) { const size_t off = (size_t)(row0 + ai * HALF + (mp + mm) * 16) * ldc + col0;
#pragma unroll
                    for (int bj = 0; bj < 2; ++bj)
#pragma unroll
                        for (int n = 0; n < 2; ++n) { const f32x4 zn = rs[mm][bj][n] * alpha + acc[ai][bj][mp + mm][n];
                            *(unsigned long long*)(Z + off + bj * HALF + n * 16) = ((unsigned long long)pk_h2(zn[2], zn[3]) << 32) | pk_h2(zn[0], zn[1]); } }
                asm volatile("" ::: "memory"); }
        }
    }
};
struct EpiSwiGlu {
    static constexpr bool PERM = true, AFTER_DRAIN = false;
    bf16_t* O; int ldc; size_t bs;
    __device__ __forceinline__ void operator()(const f32x4 (&acc)[2][2][4][2], const Unit& u, int wr, int wc, int fr, int fq) const {
        const int row0 = u.pm * BM + wr * 64 + fr, col0 = u.pn * HALF + wc * 32 + 8 * fq;
        bf16_t* Ob = O + (size_t)(row0 >> 11) * bs + col0; const int lr0 = row0 & 2047;
#pragma unroll
        for (int ai = 0; ai < 2; ++ai)
#pragma unroll
            for (int m = 0; m < 4; ++m) { bf16_t* rowp = Ob + (size_t)(lr0 + ai * HALF + m * 16) * ldc;
                float o[8];
#pragma unroll
                for (int n = 0; n < 2; ++n)
#pragma unroll
                    for (int j = 0; j < 4; ++j) { const float g = acc[ai][0][m][n][j], up = acc[ai][1][m][n][j]; o[4 * n + j] = g * sigmoidf_(g) * up; }
                u32x4 w; w.x = cvt_pk_bf16(o[0], o[1]); w.y = cvt_pk_bf16(o[2], o[3]); w.z = cvt_pk_bf16(o[4], o[5]); w.w = cvt_pk_bf16(o[6], o[7]);
                *(u32x4*)rowp = w; }
    }
};

template <class Epi, class Sched, bool ALIGN_EPI = false, bool SP2 = false>
__device__ __forceinline__ void gemm_phase(PG8_LAS unsigned char* lds, const Gemm g, const Sched& S, const Epi& E) {
    const int tid = threadIdx.x, wid = __builtin_amdgcn_readfirstlane(tid >> 6), lane = tid & 63, wr = wid >> 2, wc = wid & 3, fr = lane & 15, fq = lane >> 4;
    const int K = g.K, nt = K / BK;
    unsigned voffA[2], voffB[2];
#pragma unroll
    for (int i = 0; i < 2; ++i) { int R, C; stage_rc(tid * 16 + i * 8192, R, C); const int Rb = Epi::PERM ? ((R & ~31) + perm32(R & 31)) : R;
        voffA[i] = (unsigned)(R * K + C) * 2u; voffB[i] = (unsigned)(Rb * K + C) * 2u; }
    const size_t kstep = (size_t)(BK * 2);
    const size_t hstep = (size_t)HALF * K * 2;
    const size_t tstep = 2 * hstep;
    const unsigned ldsw = (unsigned)wid * 1024u;
    const int aoff = lds_byte(wr * 64 + fr, fq * 8), boff = lds_byte(wc * 32 + fr, fq * 8);
#define PG8_SA(b, h) (((b) * 2 + (h)) * HTB)
#define PG8_SB(b, h) ((4 + (b) * 2 + (h)) * HTB)
#define PG8_STAGE(bufoff, gbase, voff) do { _Pragma("unroll") for (int _i = 0; _i < 2; ++_i) \
        __builtin_amdgcn_global_load_lds((const unsigned*)((const char*)(gbase) + (voff)[_i]), (PG8_LAS unsigned*)(lds + (bufoff) + ldsw + _i * 8192), 16, 0, 0); } while (0)
#define PG8_LDA(dst, b, h) do { _Pragma("unroll") for (int m = 0; m < 4; ++m) _Pragma("unroll") for (int k = 0; k < 2; ++k) dst[m][k] = *(const PG8_LAS bf16x8*)(lds + PG8_SA(b, h) + aoff + m * 2048 + k * 1024); } while (0)
#define PG8_LDB(dst, b, h) do { _Pragma("unroll") for (int n = 0; n < 2; ++n) _Pragma("unroll") for (int k = 0; k < 2; ++k) dst[n][k] = *(const PG8_LAS bf16x8*)(lds + PG8_SB(b, h) + boff + n * 2048 + k * 1024); } while (0)
#define PG8_MMA(ai, bj, At, Bt) do { __builtin_amdgcn_s_setprio(1); _Pragma("unroll") for (int m = 0; m < 4; ++m) _Pragma("unroll") for (int n = 0; n < 2; ++n) _Pragma("unroll") for (int k = 0; k < 2; ++k) \
        acc[ai][bj][m][n] = __builtin_amdgcn_mfma_f32_16x16x32_bf16(Bt[n][k], At[m][k], acc[ai][bj][m][n], 0, 0, 0); __builtin_amdgcn_s_setprio(0); } while (0)
#define PG8_WAIT_V(n) asm volatile("s_waitcnt vmcnt(" #n ")" ::: "memory")
#define PG8_WAIT_L(n) asm volatile("s_waitcnt lgkmcnt(" #n ")" ::: "memory")
#define PG8_BAR __builtin_amdgcn_s_barrier()
#define PG8_SCHED __builtin_amdgcn_sched_barrier(0)
    Unit cur, nxt; int ui = 0;
    if (!S.next(0, cur)) return;
    f32x4 acc[2][2][4][2];
#pragma unroll
    for (int a = 0; a < 2; ++a)
#pragma unroll
        for (int b = 0; b < 2; ++b)
#pragma unroll
            for (int m = 0; m < 4; ++m)
#pragma unroll
                for (int n = 0; n < 2; ++n) acc[a][b][m][n] = (f32x4){0.f, 0.f, 0.f, 0.f};
    bf16x8 At[4][2], B0[2][2], B1[2][2];
    auto abase = [&](int pm) -> size_t { return g.bsA ? (size_t)(pm >> 3) * g.bsA + (size_t)(pm & 7) * tstep : (size_t)pm * tstep; };
    const char* cA = (const char*)g.A + abase(cur.pm); const char* cB = (const char*)g.Bt + (size_t)cur.pn * tstep;
    S.a_ready(cur);
    if constexpr (SP2) {
        PG8_STAGE(PG8_SB(0, 0), cB, voffB); PG8_STAGE(PG8_SB(0, 1), cB + hstep, voffB); PG8_STAGE(PG8_SA(0, 0), cA, voffA); PG8_STAGE(PG8_SA(0, 1), cA + hstep, voffA);
        if (wr == 1) PG8_BAR;
        PG8_WAIT_V(2); PG8_BAR;
        PG8_STAGE(PG8_SB(1, 0), cB + kstep, voffB); PG8_STAGE(PG8_SA(1, 0), cA + kstep, voffA); PG8_STAGE(PG8_SB(1, 1), cB + hstep + kstep, voffB);
        PG8_WAIT_V(6); PG8_BAR;
    } else {
        PG8_STAGE(PG8_SB(0, 0), cB, voffB); PG8_STAGE(PG8_SA(0, 0), cA, voffA); PG8_STAGE(PG8_SB(0, 1), cB + hstep, voffB); PG8_STAGE(PG8_SA(0, 1), cA + hstep, voffA);
        if (wr == 1) PG8_BAR;
        PG8_WAIT_V(4); PG8_BAR;
        PG8_STAGE(PG8_SB(1, 0), cB + kstep, voffB); PG8_STAGE(PG8_SA(1, 0), cA + kstep, voffA); PG8_STAGE(PG8_SB(1, 1), cB + hstep + kstep, voffB);
        PG8_WAIT_V(6); PG8_BAR;
    }
    for (;;) {
        const bool has_next = S.next(ui + 1, nxt);
        const char* nA = has_next ? (const char*)g.A + abase(nxt.pm) : cA; const char* nB = has_next ? (const char*)g.Bt + (size_t)nxt.pn * tstep : cB;
        for (int t = 0; t < nt; t += 2) {
            const bool last = (t == nt - 2);
            const char* a1 = cA + (size_t)(t + 1) * kstep;
            const char* a2 = last ? nA : cA + (size_t)(t + 2) * kstep; const char* b2 = last ? nB : cB + (size_t)(t + 2) * kstep;
            const char* a3 = a2 + kstep; const char* b3 = b2 + kstep;
            if (last && has_next) S.a_ready(nxt);
            if constexpr (SP2) {
            PG8_LDB(B0, 0, 0); PG8_LDB(B1, 0, 1); PG8_SCHED; PG8_LDA(At, 0, 0); PG8_STAGE(PG8_SA(1, 1), a1 + hstep, voffA);
            PG8_WAIT_V(8); PG8_WAIT_L(0); PG8_BAR; PG8_MMA(0, 0, At, B0); PG8_MMA(0, 1, At, B1); PG8_BAR; PG8_SCHED;
            PG8_LDA(At, 0, 1); PG8_STAGE(PG8_SB(0, 0), b2, voffB); PG8_STAGE(PG8_SB(0, 1), b2 + hstep, voffB); PG8_STAGE(PG8_SA(0, 0), a2, voffA);
            PG8_WAIT_V(8); PG8_WAIT_L(0); PG8_BAR; PG8_MMA(1, 0, At, B0); PG8_MMA(1, 1, At, B1); PG8_BAR; PG8_SCHED;
            PG8_LDB(B0, 1, 0); PG8_LDB(B1, 1, 1); PG8_SCHED; PG8_LDA(At, 1, 0); PG8_STAGE(PG8_SA(0, 1), a2 + hstep, voffA);
            PG8_WAIT_V(8); PG8_WAIT_L(0); PG8_BAR; PG8_MMA(0, 0, At, B0); PG8_MMA(0, 1, At, B1); PG8_BAR; PG8_SCHED;
            PG8_LDA(At, 1, 1); PG8_STAGE(PG8_SB(1, 0), b3, voffB); PG8_STAGE(PG8_SB(1, 1), b3 + hstep, voffB); PG8_STAGE(PG8_SA(1, 0), a3, voffA);
            PG8_WAIT_V(8); PG8_WAIT_L(0); PG8_BAR; PG8_MMA(1, 0, At, B0); PG8_MMA(1, 1, At, B1); PG8_BAR; PG8_SCHED;
            } else {
            PG8_LDB(B0, 0, 0); PG8_SCHED; PG8_LDA(At, 0, 0); PG8_STAGE(PG8_SA(1, 1), a1 + hstep, voffA);
            PG8_WAIT_L(8); PG8_BAR; PG8_WAIT_L(0); PG8_MMA(0, 0, At, B0); PG8_BAR; PG8_SCHED;
            PG8_LDB(B1, 0, 1); PG8_STAGE(PG8_SB(0, 0), b2, voffB);
            PG8_BAR; PG8_WAIT_L(0); PG8_MMA(0, 1, At, B1); PG8_BAR;
            PG8_LDA(At, 0, 1); PG8_STAGE(PG8_SA(0, 0), a2, voffA);
            PG8_BAR; PG8_WAIT_L(0); PG8_MMA(1, 0, At, B0); PG8_BAR; PG8_SCHED;
            PG8_STAGE(PG8_SB(0, 1), b2 + hstep, voffB);
            PG8_WAIT_V(6); PG8_BAR; PG8_MMA(1, 1, At, B1); PG8_BAR;
            PG8_LDB(B0, 1, 0); PG8_SCHED; PG8_LDA(At, 1, 0); PG8_STAGE(PG8_SA(0, 1), a2 + hstep, voffA);
            PG8_WAIT_L(8); PG8_BAR; PG8_WAIT_L(0); PG8_MMA(0, 0, At, B0); PG8_BAR; PG8_SCHED;
            PG8_LDB(B1, 1, 1); PG8_STAGE(PG8_SB(1, 0), b3, voffB);
            PG8_BAR; PG8_WAIT_L(0); PG8_MMA(0, 1, At, B1); PG8_BAR;
            PG8_LDA(At, 1, 1); PG8_STAGE(PG8_SA(1, 0), a3, voffA);
            PG8_BAR; PG8_WAIT_L(0); PG8_MMA(1, 0, At, B0); PG8_BAR; PG8_SCHED;
            PG8_STAGE(PG8_SB(1, 1), b3 + hstep, voffB);
            PG8_WAIT_V(6); PG8_BAR; PG8_MMA(1, 1, At, B1); PG8_BAR;
            }
        }
        if constexpr (ALIGN_EPI) { if (wr == 0) PG8_BAR; }
        if constexpr (!Epi::AFTER_DRAIN) { E(acc, cur, wr, wc, fr, fq); S.done(cur); }
        if (!has_next) break;
#pragma unroll
        for (int a = 0; a < 2; ++a)
#pragma unroll
            for (int b = 0; b < 2; ++b)
#pragma unroll
                for (int m = 0; m < 4; ++m)
#pragma unroll
                    for (int n = 0; n < 2; ++n) acc[a][b][m][n] = (f32x4){0.f, 0.f, 0.f, 0.f};
        cur = nxt; cA = nA; cB = nB; ++ui;
        if constexpr (ALIGN_EPI) { if (wr == 1) PG8_BAR; }
    }
    PG8_WAIT_V(0);
    if constexpr (!ALIGN_EPI) { if (wr == 0) PG8_BAR; }
    PG8_BAR;
#undef PG8_SA
#undef PG8_SB
#undef PG8_STAGE
#undef PG8_LDA
#undef PG8_LDB
#undef PG8_MMA
#undef PG8_WAIT_V
#undef PG8_WAIT_L
#undef PG8_BAR
#undef PG8_SCHED
}
}

#ifndef PG8_SP2
#define PG8_SP2 true
#endif
#ifndef PG8_ALIGN
#define PG8_ALIGN true
#endif

constexpr int NWAVES = 8;
constexpr int NPH = 17;
constexpr int N_LAUNCHES = MK_N_LAUNCHES;
static_assert(N_LAUNCHES == 1 || N_LAUNCHES == NPH, "MK_N_LAUNCHES is 1 or NPH");

constexpr int D = 4096, SEQ = 2048, BATCH = 8, M = BATCH * SEQ;
constexpr int FF = 11008, NGU = 2 * FF;
constexpr int EV_IN = 8208, N0 = 8192, OD_IN = 16384;
constexpr int S5W = 2048, S5G = 128;
constexpr float DN_ALPHA = 1.41421356237f;
constexpr float NORM_EPS = 1e-5f;

constexpr size_t MiB = 1u << 20;
constexpr size_t WS_CTL = 0, CTL_ZERO_BYTES = 1 * MiB;
constexpr size_t WS_WAF = 1 * MiB;
constexpr size_t WS_AB = WS_WAF + 128 * 1024;
constexpr size_t WS_BBF = WS_AB + 64 * 1024;
constexpr size_t WS_CRF = WS_BBF + 1 * MiB;
constexpr size_t WS_STATS = 2 * MiB + 768 * 1024;
constexpr size_t WS_ALR = 3 * MiB;
constexpr size_t WS_W_IN0 = 4 * MiB, WS_W_GLU = 68 * MiB, WS_W_OUT0 = 76 * MiB, WS_W_GU0 = 108 * MiB, WS_W_DN0 = 280 * MiB;
constexpr size_t WS_W_IN1 = 366 * MiB, WS_W_OUT1 = 494 * MiB, WS_W_GU1 = 526 * MiB, WS_W_DN1 = 698 * MiB;
constexpr size_t WS_XB = 784 * MiB;
constexpr size_t WS_YCAT = WS_XB;
constexpr size_t WS_H = 912 * MiB;
constexpr size_t WS_Z = WS_H + 512 * MiB;
constexpr size_t WS_YG = WS_Z + 128 * MiB;
constexpr size_t HSLAB_EL = (size_t)32 * 1024 * 1024;
constexpr size_t WS_GDEC = WS_Z + 256 * MiB;
constexpr size_t WS_END = WS_GDEC + 64 * MiB;
static_assert(WS_CRF + 512 * 1024 <= WS_STATS && WS_STATS + 128 * 1024 <= WS_ALR, "tables");
static_assert(WS_W_GU0 + (size_t)NGU * D * 2 <= WS_W_DN0 && WS_W_DN0 + (size_t)D * FF * 2 <= WS_W_IN1 && WS_W_GU1 + (size_t)NGU * D * 2 <= WS_W_DN1 && WS_W_DN1 + (size_t)D * FF * 2 <= WS_XB, "weights");
static_assert(WS_H + (size_t)M * OD_IN * 2 <= WS_Z && WS_Z + (size_t)M * D * 4 <= WS_END, "h");

constexpr int CW_TMO = 0, CW_CODE = 1;
constexpr int CW_BAR = 4096;

constexpr int RING_OFF = 0, RING_BYTES = 131072;
constexpr int LDSCTL_OFF = RING_BYTES, MISC_OFF = LDSCTL_OFF + 320;
constexpr int LDS_BYTES = 147456;
static_assert(MISC_OFF + 128 <= LDS_BYTES, "LDS map");

#define GAS __attribute__((address_space(1)))
#define LAS __attribute__((address_space(3)))
typedef unsigned short bf16;
typedef unsigned v4u __attribute__((ext_vector_type(4)));
typedef unsigned v2u __attribute__((ext_vector_type(2)));
typedef float f32x4 __attribute__((ext_vector_type(4)));
typedef float f32x2 __attribute__((ext_vector_type(2)));
typedef short bf16x8 __attribute__((ext_vector_type(8)));
typedef GAS unsigned gu32;
#define RLX_AGENT __ATOMIC_RELAXED, __HIP_MEMORY_SCOPE_AGENT
#define LDS_WAIT() asm volatile("s_waitcnt lgkmcnt(0)" ::: "memory")
#define VM_WAIT() asm volatile("s_waitcnt vmcnt(0)" ::: "memory")
#define CFENCE() asm volatile("" ::: "memory")
__device__ __forceinline__ unsigned pk2(float lo, float hi) { return pg8::cvt_pk_bf16(lo, hi); }
__device__ __forceinline__ float bflo(unsigned x) { return __uint_as_float(x << 16); }
__device__ __forceinline__ float bfhi(unsigned x) { return __uint_as_float(x & 0xffff0000u); }
__device__ __forceinline__ f32x4 mfma16(bf16x8 a, bf16x8 b, f32x4 c) { return __builtin_amdgcn_mfma_f32_16x16x32_bf16(a, b, c, 0, 0, 0); }

#define XB_TMO      128
#define XB_XCNT(j)  (256  + 64 * (j))
#define XB_XSUB(j)  (1280 + 64 * (j))
#define XB_XGEN(j)  (2304 + 64 * (j))
#define XB_TOP      3328
#define XB_TOPGEN   3392
#define XCD_BAR_WORDS 3456
#define XB_SPIN_CAP (1u << 18)

__device__ __forceinline__ unsigned xb_ld(unsigned* p)              { return __hip_atomic_load(p, __ATOMIC_RELAXED, __HIP_MEMORY_SCOPE_AGENT); }
__device__ __forceinline__ unsigned xb_add(unsigned* p, unsigned v) { return __hip_atomic_fetch_add(p, v, __ATOMIC_RELAXED, __HIP_MEMORY_SCOPE_AGENT); }
__device__ __forceinline__ unsigned xb_xcc_id() { return (unsigned)__builtin_amdgcn_s_getreg((3 << 11) | 20) & 0xFu; }
#define XB_SPIN(cond, bar) do { unsigned _sp = 0; while (cond) { __builtin_amdgcn_s_sleep(1); \
    if ((++_sp & 255u) == 0u) { if (xb_ld(&(bar)[XB_TMO])) break; if (_sp > XB_SPIN_CAP) { atomicAdd(&(bar)[XB_TMO], 1u); break; } } } } while (0)

struct XcdBarrier {
    unsigned* bar; unsigned x;
    volatile LAS unsigned* st;
};
__device__ __forceinline__ XcdBarrier xcd_barrier_post(unsigned* bar, volatile LAS unsigned* st) {
    XcdBarrier b; b.bar = bar; b.x = xb_xcc_id(); b.st = st;
    if (threadIdx.x == 0) (void)xb_add(&bar[XB_XCNT(b.x)], 1u);
    return b;
}
__device__ __forceinline__ void xcd_barrier_complete(unsigned* bar, unsigned x, unsigned& nloc, unsigned& nx) {
    const unsigned G = gridDim.x * gridDim.y * gridDim.z;
    unsigned sum, cnt, mine, sp = 0u;
    for (;;) {
        sum = 0u; cnt = 0u; mine = 0u;
#pragma unroll
        for (unsigned j = 0; j < 16; ++j) { const unsigned c = xb_ld(&bar[XB_XCNT(j)]); sum += c; cnt += (c > 0u) ? 1u : 0u; mine = (j == x) ? c : mine; }
        if (sum == G) break;
        __builtin_amdgcn_s_sleep(1);
        if ((++sp & 255u) == 0u) { if (xb_ld(&bar[XB_TMO])) break; if (sp > XB_SPIN_CAP) { atomicAdd(&bar[XB_TMO], 1u); break; } }
    }
    nloc = mine > 0u ? mine : 1u; nx = cnt > 0u ? cnt : 1u;
}
__device__ __forceinline__ void xcd_barrier(const XcdBarrier& b, const bool local = false) {
    asm volatile("s_waitcnt vmcnt(0)" ::: "memory");
    __syncthreads();
    if (threadIdx.x == 0) {
        unsigned* bar = b.bar;
        __builtin_amdgcn_s_waitcnt(0);
        unsigned nloc = b.st[0], nx = b.st[1];
        if (nloc == 0u) { xcd_barrier_complete(bar, b.x, nloc, nx); b.st[0] = nloc; b.st[1] = nx; }
        const unsigned old = xb_add(&bar[XB_XSUB(b.x)], 1u);
        const unsigned gen = old / nloc;
        if (old + 1u == (gen + 1u) * nloc) {
            if (!local) {
                __builtin_amdgcn_fence(__ATOMIC_RELEASE, "agent");
                asm volatile("s_waitcnt vmcnt(0)" ::: "memory");
                const unsigned og = xb_add(&bar[XB_TOP], 1u);
                const unsigned tg = og / nx;
                if (og + 1u == (tg + 1u) * nx) xb_add(&bar[XB_TOPGEN], 1u);
                else XB_SPIN(xb_ld(&bar[XB_TOPGEN]) == tg, bar);
            }
            __builtin_amdgcn_fence(__ATOMIC_ACQUIRE, "agent");
            xb_add(&bar[XB_XGEN(b.x)], 1u);
            asm volatile("s_waitcnt vmcnt(0)" ::: "memory");
        } else {
            XB_SPIN(xb_ld(&bar[XB_XGEN(b.x)]) == gen, bar);
            __builtin_amdgcn_fence(__ATOMIC_ACQUIRE, "agent");
            asm volatile("s_waitcnt vmcnt(0)" ::: "memory");
        }
    }
    __syncthreads();
}

struct Args { const float* in[26]; float* out; unsigned char* ws; int ph_lo, ph_hi, li, pad; };
struct Frame {
    LAS unsigned char* lds;
    volatile LAS unsigned* MISC;
    gu32* ctl;
    int tid, lane, wave;
    int vcu, G;
    float* out;
    unsigned char* ws;
};
enum { I_X = 0, I_EV_W_IN, I_EV_W_OUT, I_S5_LAM_RE, I_S5_LAM_IM, I_S5_LOG_DT, I_S5_B_RE, I_S5_B_IM, I_S5_C_RE, I_S5_C_IM, I_S5_D, I_S5_W_GLU,
       I_GLA_W_ALPHA, I_GLA_B_ALPHA, I_GLA_NORM_G, I_OD_W_IN, I_OD_W_OUT, I_HG_LB, I_HG_NORM_G, I_LN_MIX_G, I_LN_MIX_B, I_LN_FFN_G, I_LN_FFN_B,
       I_FFN_W_GATE, I_FFN_W_UP, I_FFN_W_DOWN };

__device__ __forceinline__ float wave_sum(float v) {
#pragma unroll
    for (int o = 1; o < 64; o <<= 1) v += __shfl_xor(v, o);
    return v;
}

struct P0Item { const GAS float* src; size_t ldw; bf16* dst; size_t K8; };
__device__ __forceinline__ void p0_item_make(P0Item& d, const float* W, int K, int ldw, int nblk, bf16* WT, int mode, int item, int lane) {
    const int kb_ = item / nblk, nb = item - kb_ * nblk, k0 = 64 * kb_, n0 = 64 * nb;
    const int ng = lane & 15, kg = lane >> 4;
    d.src = (const GAS float*)W + (size_t)(k0 + 16 * kg) * ldw + n0 + 4 * ng; d.ldw = (size_t)ldw;
    const int rbase = (mode == 0) ? n0 : ((n0 >> 7) * 256 + (n0 & 127) + (mode == 2 ? 128 : 0));
    d.dst = WT + (size_t)(rbase + (lane >> 3)) * K + k0 + 8 * (lane & 7); d.K8 = (size_t)8 * K;
}
__device__ __forceinline__ void p0_item_load(const P0Item& d, f32x4 (&v)[2][8]) {
#pragma unroll
    for (int kb = 0; kb < 2; ++kb)
#pragma unroll
        for (int i = 0; i < 8; ++i) v[kb][i] = __builtin_nontemporal_load((const GAS f32x4*)(d.src + (size_t)(8 * kb + i) * d.ldw));
}
__device__ __forceinline__ void p0_item_finish(const P0Item& d, const f32x4 (&v)[2][8], LAS bf16* img, int lane) {
    const int ng = lane & 15, kg = lane >> 4;
#pragma unroll
    for (int kb = 0; kb < 2; ++kb)
#pragma unroll
        for (int j = 0; j < 4; ++j) {
            v4u o; o.x = pk2(v[kb][0][j], v[kb][1][j]); o.y = pk2(v[kb][2][j], v[kb][3][j]); o.z = pk2(v[kb][4][j], v[kb][5][j]); o.w = pk2(v[kb][6][j], v[kb][7][j]);
            *(LAS v4u*)(img + (4 * ng + j) * 72 + 16 * kg + 8 * kb) = o;
        }
    LDS_WAIT(); CFENCE();
#pragma unroll
    for (int j = 0; j < 8; ++j) { const int n = (lane >> 3) + 8 * j, c = lane & 7;
        const v4u o = *(const LAS v4u*)(img + n * 72 + 8 * c);
        *(GAS v4u*)(d.dst + (size_t)j * d.K8) = o; }
    LDS_WAIT(); CFENCE();
}

__device__ __forceinline__ void s5_disc(const Args& A, int g, int p, double& ar, double& ai, double& fr, double& fi) {
    const double dt = exp((double)A.in[I_S5_LOG_DT][g]);
    const double lr = (double)A.in[I_S5_LAM_RE][g * 64 + p], li = (double)A.in[I_S5_LAM_IM][g * 64 + p];
    const double mag = exp(lr * dt), th = li * dt;
    ar = mag * cos(th); ai = mag * sin(th);
    const double nr = ar - 1.0, ni = ai, den = lr * lr + li * li;
    fr = (nr * lr + ni * li) / den; fi = (ni * lr - nr * li) / den;
}

constexpr int IT_IN0 = (D / 64) * (N0 / 64), IT_GLU = (S5W / 64) * (S5W / 64), IT_OUT = (D / 64) * (D / 64), IT_G = (D / 64) * (FF / 64), IT_DN = (FF / 64) * (D / 64), IT_IN1 = (D / 64) * (OD_IN / 64);
constexpr int NITEMS = IT_IN0 + IT_GLU + 2 * IT_OUT + 4 * IT_G + 2 * IT_DN + IT_IN1;
constexpr int NITEMS_P14 = NITEMS - IT_DN;
constexpr int NITEMS_P7 = NITEMS_P14 - IT_G;
constexpr int NITEMS_P3B = NITEMS_P7 - IT_IN1 - IT_OUT - IT_DN;
constexpr int NITEMS_EARLY = NITEMS_P3B - IT_G;
__device__ __forceinline__ void p0a_phase(Frame& F, const Args& A, const bool tables, const int gw, const int NGW, const int it_lo, const int it_hi) {
    LAS bf16* scr = (LAS bf16*)(F.lds + RING_OFF + F.wave * 16384);
    if (tables) {
        const int gt = (F.vcu * NWAVES * 64) + F.tid;
        if (gt < 65536) {
            const int g = gt >> 9, n = (gt >> 6) & 7, l = gt & 63, q = l >> 4, pr = 16 * n + (l & 15);
            v4u o = (v4u){0u, 0u, 0u, 0u};
            if (q < 2) {
                const int p = pr & 63; double ar, ai, fr, fi; s5_disc(A, g, p, ar, ai, fr, fi);
                const float* bre = A.in[I_S5_B_RE] + ((size_t)g * 64 + p) * 16 + 8 * q; const float* bim = A.in[I_S5_B_IM] + ((size_t)g * 64 + p) * 16 + 8 * q;
                float v[8];
#pragma unroll
                for (int e = 0; e < 8; ++e) { const double br = bre[e], bi = bim[e]; v[e] = (float)((pr < 64) ? (fr * br - fi * bi) : (fr * bi + fi * br)); }
                o.x = pk2(v[0], v[1]); o.y = pk2(v[2], v[3]); o.z = pk2(v[4], v[5]); o.w = pk2(v[6], v[7]);
            }
            *(GAS v4u*)(F.ws + WS_BBF + (size_t)gt * 16) = o;
        } else if (gt < 65536 + 32768) {
            const int t = gt - 65536, g = t >> 8, ks = (t >> 6) & 3, l = t & 63, q = l >> 4, i = l & 15;
            float v[8];
#pragma unroll
            for (int e = 0; e < 8; ++e) { const int pp = 32 * ks + 8 * q + e; v[e] = (pp < 64) ? A.in[I_S5_C_RE][((size_t)g * 16 + i) * 64 + pp] : -A.in[I_S5_C_IM][((size_t)g * 16 + i) * 64 + (pp - 64)]; }
            v4u o; o.x = pk2(v[0], v[1]); o.y = pk2(v[2], v[3]); o.z = pk2(v[4], v[5]); o.w = pk2(v[6], v[7]);
            *(GAS v4u*)(F.ws + WS_CRF + (size_t)t * 16) = o;
        } else if (gt < 65536 + 32768 + 8192) {
            const int t = gt - 98304, g = t >> 6, p = t & 63; double ar, ai, fr, fi; s5_disc(A, g, p, ar, ai, fr, fi);
            *(GAS f32x2*)(F.ws + WS_AB + (size_t)t * 8) = (f32x2){(float)ar, (float)ai};
        } else if (gt < 65536 + 32768 + 8192 + 8192) {
            const int t = gt - 106496, ks = t >> 6, l = t & 63, q = l >> 4, n = l & 15;
            float v[8];
#pragma unroll
            for (int e = 0; e < 8; ++e) v[e] = A.in[I_EV_W_IN][(size_t)(32 * ks + 8 * q + e) * EV_IN + N0 + n];
            v4u o; o.x = pk2(v[0], v[1]); o.y = pk2(v[2], v[3]); o.z = pk2(v[4], v[5]); o.w = pk2(v[6], v[7]);
            *(GAS v4u*)(F.ws + WS_WAF + (size_t)t * 16) = o;
        }
    }
    auto decode = [&](int it, P0Item& d) {
        int r = it;
        if (r < IT_IN0) { p0_item_make(d, A.in[I_EV_W_IN], D, EV_IN, N0 / 64, (bf16*)(F.ws + WS_W_IN0), 0, r, F.lane); return; } r -= IT_IN0;
        if (r < IT_GLU) { p0_item_make(d, A.in[I_S5_W_GLU], S5W, S5W, S5W / 64, (bf16*)(F.ws + WS_W_GLU), 0, r, F.lane); return; } r -= IT_GLU;
        if (r < IT_OUT) { p0_item_make(d, A.in[I_EV_W_OUT], D, D, D / 64, (bf16*)(F.ws + WS_W_OUT0), 0, r, F.lane); return; } r -= IT_OUT;
        if (r < IT_G) { p0_item_make(d, A.in[I_FFN_W_GATE], D, FF, FF / 64, (bf16*)(F.ws + WS_W_GU0), 1, r, F.lane); return; } r -= IT_G;
        if (r < IT_G) { p0_item_make(d, A.in[I_FFN_W_UP], D, FF, FF / 64, (bf16*)(F.ws + WS_W_GU0), 2, r, F.lane); return; } r -= IT_G;
        if (r < IT_G) { p0_item_make(d, A.in[I_FFN_W_UP] + (size_t)D * FF, D, FF, FF / 64, (bf16*)(F.ws + WS_W_GU1), 2, r, F.lane); return; } r -= IT_G;
        if (r < IT_DN) { p0_item_make(d, A.in[I_FFN_W_DOWN], FF, D, D / 64, (bf16*)(F.ws + WS_W_DN0), 0, r, F.lane); return; } r -= IT_DN;
        if (r < IT_OUT) { p0_item_make(d, A.in[I_OD_W_OUT], D, D, D / 64, (bf16*)(F.ws + WS_W_OUT1), 0, r, F.lane); return; } r -= IT_OUT;
        if (r < IT_IN1) { p0_item_make(d, A.in[I_OD_W_IN], D, OD_IN, OD_IN / 64, (bf16*)(F.ws + WS_W_IN1), 0, r, F.lane); return; } r -= IT_IN1;
        if (r < IT_G) { p0_item_make(d, A.in[I_FFN_W_GATE] + (size_t)D * FF, D, FF, FF / 64, (bf16*)(F.ws + WS_W_GU1), 1, r, F.lane); return; } r -= IT_G;
        p0_item_make(d, A.in[I_FFN_W_DOWN] + (size_t)FF * D, FF, D, D / 64, (bf16*)(F.ws + WS_W_DN1), 0, r, F.lane);
    };
    int it = it_lo + gw;
    if (it < it_hi) {
        P0Item d0, d1, d2; f32x4 v0[2][8], v1[2][8], v2[2][8];
        decode(it, d0); p0_item_load(d0, v0);
        bool h1 = it + NGW < it_hi;
        if (h1) { decode(it + NGW, d1); p0_item_load(d1, v1); }
        for (;;) {
            bool h2 = h1 && (it + 2 * NGW < it_hi);
            if (h2) { decode(it + 2 * NGW, d2); p0_item_load(d2, v2); }
            p0_item_finish(d0, v0, scr, F.lane);
            if (!h1) break;
            it += NGW;
            bool h0 = h2 && (it + 2 * NGW < it_hi);
            if (h0) { decode(it + 2 * NGW, d0); p0_item_load(d0, v0); }
            p0_item_finish(d1, v1, scr, F.lane);
            if (!h2) break;
            it += NGW;
            h1 = h0 && (it + 2 * NGW < it_hi);
            if (h1) { decode(it + 2 * NGW, d1); p0_item_load(d1, v1); }
            p0_item_finish(d2, v2, scr, F.lane);
            if (!h0) break;
            it += NGW;
        }
    }
}

__device__ __forceinline__ void p0b_phase(Frame& F, const Args& A) {
    const int lane = F.lane, fr = lane & 15, fq = lane >> 4, w = F.wave;
    LAS float* red = (LAS float*)(F.lds + RING_OFF);
    const bf16* waf = (const bf16*)(F.ws + WS_WAF);
    bf16* XB = (bf16*)(F.ws + WS_XB);
    float* ALR = (float*)(F.ws + WS_ALR);
    float* GD = (float*)(F.ws + WS_GDEC);
    LAS float* alr_l = red + 1024;
    f32x2 wa[16];
#pragma unroll
    for (int r = 0; r < 16; ++r) wa[r] = *(const GAS f32x2*)(A.in[I_GLA_W_ALPHA] + r * 1024 + 2 * F.tid);
    const f32x2 ba2 = *(const GAS f32x2*)(A.in[I_GLA_B_ALPHA] + 2 * F.tid);
    for (int tb = F.vcu; tb < M / 64; tb += F.G) {
        const int row0 = 16 * (4 * tb + (w & 3)), kh = w >> 2;
        const float* xr = A.in[I_X] + (size_t)(row0 + fr) * D + 8 * fq;
        bf16* xo = XB + (size_t)(row0 + fr) * D + 8 * fq;
        f32x4 acc = (f32x4){0.f, 0.f, 0.f, 0.f};
#pragma unroll 4
        for (int ks = 64 * kh; ks < 64 * kh + 64; ++ks) {
            const f32x4 a0 = *(const GAS f32x4*)(xr + 32 * ks), a1 = *(const GAS f32x4*)(xr + 32 * ks + 4);
            v4u pa; pa.x = pk2(a0[0], a0[1]); pa.y = pk2(a0[2], a0[3]); pa.z = pk2(a1[0], a1[1]); pa.w = pk2(a1[2], a1[3]);
            *(GAS v4u*)(xo + 32 * ks) = pa;
            const v4u pb = *(const GAS v4u*)(waf + ((size_t)ks * 64 + lane) * 8);
            acc = mfma16(__builtin_bit_cast(bf16x8, pa), __builtin_bit_cast(bf16x8, pb), acc);
        }
        if (kh == 1) *(LAS f32x4*)(red + ((w & 3) * 64 + lane) * 4) = acc;
        __syncthreads();
        if (kh == 0) { const f32x4 o = acc + *(LAS f32x4*)(red + ((w & 3) * 64 + lane) * 4);
#pragma unroll
            for (int r = 0; r < 4; ++r) { ALR[(size_t)(row0 + 4 * fq + r) * 16 + fr] = o[r]; alr_l[(16 * (w & 3) + 4 * fq + r) * 16 + fr] = o[r]; } }
        __syncthreads();
        for (int t = 0; t < 64; ++t) {
            float z0 = ba2.x, z1 = ba2.y;
#pragma unroll
            for (int r4 = 0; r4 < 4; ++r4) { const f32x4 t4 = *(const LAS f32x4*)(alr_l + t * 16 + 4 * r4);
                z0 += t4.x * wa[4 * r4].x + t4.y * wa[4 * r4 + 1].x + t4.z * wa[4 * r4 + 2].x + t4.w * wa[4 * r4 + 3].x;
                z1 += t4.x * wa[4 * r4].y + t4.y * wa[4 * r4 + 1].y + t4.z * wa[4 * r4 + 2].y + t4.w * wa[4 * r4 + 3].y; }
            const float l0 = __log2f(1.f + __expf(-z0)), l1 = __log2f(1.f + __expf(-z1));
            *(GAS f32x2*)(GD + (size_t)(64 * tb + t) * 1024 + 2 * F.tid) = (f32x2){__builtin_amdgcn_exp2f(l0 * (-1.f / 16.f)), __builtin_amdgcn_exp2f(l1 * (-1.f / 16.f))};
        }
        __syncthreads();
    }
}

__device__ __forceinline__ void ln_phase(Frame& F, const bf16* z, const float* gam, const float* bet, float* outf, bf16* outb, float* stats) {
    const int RPW = M / (F.G * NWAVES), gw = (F.vcu * NWAVES + F.wave) * RPW, NGW = 1, MEND = gw + RPW;
    LAS float* gl = (LAS float*)(F.lds + RING_OFF); LAS float* bl = gl + D;
    for (int i = F.tid; i < D / 4; i += NWAVES * 64) { *(LAS f32x4*)(gl + 4 * i) = *(const GAS f32x4*)(gam + 4 * i); *(LAS f32x4*)(bl + 4 * i) = *(const GAS f32x4*)(bet + 4 * i); }
    __syncthreads();
    v4u pre[8];
    if (gw < M) { const GAS v4u* zr = (const GAS v4u*)(z + (size_t)gw * D) + F.lane;
#pragma unroll
        for (int j = 0; j < 8; ++j) pre[j] = zr[64 * j]; }
    for (int m = gw; m < MEND; m += NGW) {
        float v[8][8]; float s = 0.f;
#pragma unroll
        for (int j = 0; j < 8; ++j) { const v4u p = pre[j];
            v[j][0] = pg8::hflo(p.x); v[j][1] = pg8::hfhi(p.x); v[j][2] = pg8::hflo(p.y); v[j][3] = pg8::hfhi(p.y); v[j][4] = pg8::hflo(p.z); v[j][5] = pg8::hfhi(p.z); v[j][6] = pg8::hflo(p.w); v[j][7] = pg8::hfhi(p.w);
            s += ((v[j][0] + v[j][1]) + (v[j][2] + v[j][3])) + ((v[j][4] + v[j][5]) + (v[j][6] + v[j][7])); }
        if (m + NGW < MEND) { const GAS v4u* zn = (const GAS v4u*)(z + (size_t)(m + NGW) * D) + F.lane;
#pragma unroll
            for (int j = 0; j < 8; ++j) pre[j] = zn[64 * j]; }
        const float mean = wave_sum(s) * (1.f / D); float s2 = 0.f;
#pragma unroll
        for (int j = 0; j < 8; ++j)
#pragma unroll
            for (int e = 0; e < 8; ++e) { v[j][e] -= mean; s2 += v[j][e] * v[j][e]; }
        const float rstd = 1.f / sqrtf(wave_sum(s2) * (1.f / D) + NORM_EPS);
        if (stats && F.lane == 0) *(GAS f32x2*)(stats + 2 * m) = (f32x2){mean, rstd};
#pragma unroll
        for (int j = 0; j < 8; ++j) { const int e0 = 8 * (F.lane + 64 * j);
            const f32x4 g0 = *(const LAS f32x4*)(gl + e0), g1 = *(const LAS f32x4*)(gl + e0 + 4), b0 = *(const LAS f32x4*)(bl + e0), b1 = *(const LAS f32x4*)(bl + e0 + 4);
            const f32x4 o0 = (f32x4){v[j][0], v[j][1], v[j][2], v[j][3]} * rstd * g0 + b0, o1 = (f32x4){v[j][4], v[j][5], v[j][6], v[j][7]} * rstd * g1 + b1;
            if (outf) { *(GAS f32x4*)(outf + (size_t)m * D + e0) = o0; *(GAS f32x4*)(outf + (size_t)m * D + e0 + 4) = o1; }
            if (outb) { v4u pb; pb.x = pk2(o0.x, o0.y); pb.y = pk2(o0.z, o0.w); pb.z = pk2(o1.x, o1.y); pb.w = pk2(o1.z, o1.w); *(GAS v4u*)(outb + (size_t)m * D + e0) = pb; } }
    }
    __syncthreads();
}

__device__ __forceinline__ float gelu_tanh(float y) {
    const float a = 0.7978845608028654f * (y + 0.044715f * y * y * y);
    const float e = __expf(2.f * a);
    const float th = 1.f - 2.f * __builtin_amdgcn_rcpf(1.f + e);
    return 0.5f * y * (1.f + th);
}
__device__ __forceinline__ void s5_wave_unit(Frame& F, const Args& A, int b, int g, LAS unsigned char* wl) {
    const int lane = F.lane, fr = lane & 15, fq = lane >> 4;
    LAS float* BUl = (LAS float*)wl;
    LAS bf16* Xl = (LAS bf16*)(wl + 16 * 132 * 4);
    bf16x8 bbA[8], crA[4];
#pragma unroll
    for (int n = 0; n < 8; ++n) bbA[n] = __builtin_bit_cast(bf16x8, *(const GAS v4u*)(F.ws + WS_BBF + ((size_t)(g * 8 + n) * 64 + lane) * 16));
#pragma unroll
    for (int k = 0; k < 4; ++k) crA[k] = __builtin_bit_cast(bf16x8, *(const GAS v4u*)(F.ws + WS_CRF + ((size_t)(g * 4 + k) * 64 + lane) * 16));
    const f32x2 ab = *(const GAS f32x2*)(F.ws + WS_AB + ((size_t)g * 64 + lane) * 8);
    const float ar = ab.x, ai = ab.y;
    float dsk[4];
#pragma unroll
    for (int r = 0; r < 4; ++r) dsk[r] = A.in[I_S5_D][16 * g + 4 * fq + r];
    float xr = 0.f, xi = 0.f;
    const bf16* up = (const bf16*)(F.ws + WS_H) + (size_t)(b * SEQ) * N0 + 16 * g;
    bf16* yp = (bf16*)(F.ws + WS_YG) + (size_t)(b * SEQ) * S5W + 16 * g;
    v4u ub = (v4u){0u, 0u, 0u, 0u};
    if (fq < 2) ub = *(const GAS v4u*)(up + (size_t)fr * N0 + 8 * fq);
    for (int blk = 0; blk < SEQ / 16; ++blk) {
        const int tok0 = 16 * blk;
        const bf16x8 ubf = __builtin_bit_cast(bf16x8, ub);
        const v2u u4 = *(const GAS v2u*)(up + (size_t)(tok0 + fr) * N0 + 4 * fq);
        v4u ubn = (v4u){0u, 0u, 0u, 0u};
        if (fq < 2 && blk + 1 < SEQ / 16) ubn = *(const GAS v4u*)(up + (size_t)(tok0 + 16 + fr) * N0 + 8 * fq);
#pragma unroll
        for (int n = 0; n < 8; ++n) { const f32x4 d = mfma16(bbA[n], ubf, (f32x4){0.f, 0.f, 0.f, 0.f}); *(LAS f32x4*)(BUl + fr * 132 + 16 * n + 4 * fq) = d; }
        CFENCE();
#pragma unroll
        for (int t = 0; t < 16; ++t) {
            const float bre = BUl[t * 132 + lane], bim = BUl[t * 132 + 64 + lane];
            const float nxr = ar * xr - ai * xi + bre, nxi = ar * xi + ai * xr + bim; xr = nxr; xi = nxi;
            Xl[t * 136 + lane] = (bf16)(pk2(xr, 0.f) & 0xffffu); Xl[t * 136 + 64 + lane] = (bf16)(pk2(xi, 0.f) & 0xffffu);
        }
        CFENCE();
        f32x4 acc = (f32x4){0.f, 0.f, 0.f, 0.f};
#pragma unroll
        for (int k = 0; k < 4; ++k) { const bf16x8 bx = *(const LAS bf16x8*)(Xl + fr * 136 + 32 * k + 8 * fq); acc = mfma16(crA[k], bx, acc); }
        CFENCE();
        const float u0 = bflo(u4.x), u1 = bfhi(u4.x), u2 = bflo(u4.y), u3 = bfhi(u4.y);
        const float y0 = gelu_tanh(acc[0] + dsk[0] * u0), y1 = gelu_tanh(acc[1] + dsk[1] * u1), y2 = gelu_tanh(acc[2] + dsk[2] * u2), y3 = gelu_tanh(acc[3] + dsk[3] * u3);
        v2u o; o.x = pk2(y0, y1); o.y = pk2(y2, y3);
        *(GAS v2u*)(yp + (size_t)(tok0 + fr) * S5W + 4 * fq) = o;
        ub = ubn;
    }
}

template <int MODE>
__device__ __forceinline__ void chunk_mixer_unit(Frame& F, const Args& A, int b, int h) {
    constexpr int NVT = MODE == 0 ? 2 : 1, DV = 128 * NVT;
    constexpr int LDH = MODE == 0 ? N0 : OD_IN;
    constexpr int QCOL = MODE == 0 ? 2048 : 0, KCOL = MODE == 0 ? 3072 : 4096, VCOL = MODE == 0 ? 4096 : 8192, GCOL = MODE == 0 ? 6144 : 12288, YCOL = MODE == 0 ? 2048 : 0;
    constexpr int VPT = MODE == 0 ? 4 : 2;
    LAS unsigned char* L = F.lds;
    LAS bf16* QD = (LAS bf16*)(L + 0);
    LAS bf16* KI = (LAS bf16*)(L + 17408);
    LAS bf16* KE = (LAS bf16*)(L + 34816);
    LAS bf16* SC = (LAS bf16*)(L + 53248);
    LAS float* DEC = (LAS float*)(L + 62464);
    LAS float* XCH = (LAS float*)(L + 62976);
    LAS float* PART = (LAS float*)(L + 67072);
    LAS bf16* VT = (LAS bf16*)(L + 69120);
    const int tid = F.tid, lane = F.lane, w = tid >> 6, cp = lane, fr = lane & 15, fq = lane >> 4, c0 = 2 * cp;
    const bf16* Hb = (const bf16*)(F.ws + WS_H) + (size_t)(b * SEQ) * LDH;
    bf16* Yb = (bf16*)(F.ws + WS_YCAT) + (size_t)(b * SEQ) * D + YCOL + h * DV;
    const bf16* hq = Hb + QCOL + h * 128 + c0;
    const bf16* hk = Hb + KCOL + h * 128 + c0;
    const bf16* hv = Hb + VCOL + h * DV + VPT * cp;
    const bf16* hg = Hb + GCOL + h * DV;
    float lb[2], ba[2];
    if constexpr (MODE == 1) {
#pragma unroll
        for (int e = 0; e < 2; ++e) { const float t0 = A.in[I_HG_LB][h * 128 + c0 + e], t1 = A.in[I_HG_LB][D + h * 128 + c0 + e]; lb[e] = 1.f / (1.f + __expf(t0 - t1)); }
    } else {
#pragma unroll
        for (int e = 0; e < 2; ++e) ba[e] = A.in[I_GLA_B_ALPHA][h * 128 + c0 + e];
    }
    float gn[NVT][4];
#pragma unroll
    for (int vt = 0; vt < NVT; ++vt)
#pragma unroll
        for (int r = 0; r < 4; ++r) gn[vt][r] = (MODE == 0 ? A.in[I_GLA_NORM_G] : A.in[I_HG_NORM_G])[16 * (NVT * w + vt) + 4 * fq + r];
    f32x4 Sacc[NVT][8];
#pragma unroll
    for (int vt = 0; vt < NVT; ++vt)
#pragma unroll
        for (int dt = 0; dt < 8; ++dt) Sacc[vt][dt] = (f32x4){0.f, 0.f, 0.f, 0.f};
    unsigned q2[8], k2[8]; v2u v4[8]; f32x2 dcv[8];
    const float* gdp = (const float*)(F.ws + WS_GDEC) + (size_t)(b * SEQ + 8 * w) * 1024 + h * 128 + c0;
#define MIX_LOAD(c) do { _Pragma("unroll") for (int j = 0; j < 8; ++j) { const size_t ro = (size_t)(64 * (c) + 8 * w + j) * LDH; \
        q2[j] = __builtin_nontemporal_load((const GAS unsigned*)(hq + ro)); k2[j] = __builtin_nontemporal_load((const GAS unsigned*)(hk + ro)); \
        if (MODE == 0) dcv[j] = __builtin_nontemporal_load((const GAS f32x2*)(gdp + (size_t)(64 * (c) + j) * 1024)); \
        if (MODE == 0) v4[j] = __builtin_nontemporal_load((const GAS v2u*)(hv + ro)); else { v4[j].x = __builtin_nontemporal_load((const GAS unsigned*)(hv + ro)); v4[j].y = 0u; } } } while (0)
    MIX_LOAD(0);
    for (int c = 0; c < SEQ / 64; ++c) {
        float kk[8][2], cs[8][2];
        unsigned vtw[VPT][4];
        if constexpr (MODE == 1) {
            float vv[8][2];
#pragma unroll
            for (int j = 0; j < 8; ++j)
#pragma unroll
                for (int e = 0; e < 2; ++e) {
                    const float fl = e ? bfhi(k2[j]) : bflo(k2[j]);
                    const float tt = __expf(-fl), sg = __builtin_amdgcn_rcpf(1.f + tt);
                    const float f = lb[e] + (1.f - lb[e]) * sg;
                    cs[j][e] = f; kk[j][e] = (1.f - lb[e]) * (tt * sg);
                    const float iv = e ? bfhi(v4[j].x) : bflo(v4[j].x);
                    vv[j][e] = iv * __builtin_amdgcn_rcpf(1.f + __expf(-iv));
                }
#pragma unroll
            for (int jp = 0; jp < 4; ++jp) { vtw[0][jp] = pk2(vv[2 * jp][0], vv[2 * jp + 1][0]); vtw[1][jp] = pk2(vv[2 * jp][1], vv[2 * jp + 1][1]); }
        } else {
#pragma unroll
            for (int j = 0; j < 8; ++j) { cs[j][0] = dcv[j].x; cs[j][1] = dcv[j].y; }
        }
#pragma unroll
        for (int j = 1; j < 8; ++j) { cs[j][0] *= cs[j - 1][0]; cs[j][1] *= cs[j - 1][1]; }
        *(LAS f32x2*)(XCH + w * 128 + c0) = (f32x2){cs[7][0], cs[7][1]};
        __syncthreads();
        float off[2] = {1.f, 1.f}, bend[2] = {1.f, 1.f};
#pragma unroll
        for (int ww = 0; ww < 8; ++ww) { const f32x2 t2 = *(const LAS f32x2*)(XCH + ww * 128 + c0); if (ww < w) { off[0] *= t2.x; off[1] *= t2.y; } bend[0] *= t2.x; bend[1] *= t2.y; }
        {
            unsigned ke[2][4];
#pragma unroll
            for (int j = 0; j < 8; j += 2) {
                float qd[2][2], ki[2][2], kev[2][2];
#pragma unroll
                for (int jj = 0; jj < 2; ++jj)
#pragma unroll
                    for (int e = 0; e < 2; ++e) { const float pq = cs[j + jj][e] * off[e];
                        const float qv = (e ? bfhi(q2[j + jj]) : bflo(q2[j + jj])) * (MODE == 0 ? 0.08838834764831845f : 1.f);
                        const float kv_ = (MODE == 1) ? kk[j + jj][e] : (e ? bfhi(k2[j + jj]) : bflo(k2[j + jj]));
                        qd[jj][e] = qv * pq; ki[jj][e] = kv_ * __builtin_amdgcn_rcpf(pq); kev[jj][e] = ki[jj][e] * bend[e]; }
                *(LAS unsigned*)(QD + (8 * w + j) * 136 + c0) = pk2(qd[0][0], qd[0][1]); *(LAS unsigned*)(QD + (8 * w + j + 1) * 136 + c0) = pk2(qd[1][0], qd[1][1]);
                *(LAS unsigned*)(KI + (8 * w + j) * 136 + c0) = pk2(ki[0][0], ki[0][1]); *(LAS unsigned*)(KI + (8 * w + j + 1) * 136 + c0) = pk2(ki[1][0], ki[1][1]);
                ke[0][j >> 1] = pk2(kev[0][0], kev[1][0]); ke[1][j >> 1] = pk2(kev[0][1], kev[1][1]);
            }
#pragma unroll
            for (int e = 0; e < 2; ++e) *(LAS v4u*)(KE + (c0 + e) * 72 + 8 * w) = (v4u){ke[e][0], ke[e][1], ke[e][2], ke[e][3]};
            if constexpr (MODE == 0) {
#pragma unroll
                for (int jp = 0; jp < 4; ++jp) { const int j = 2 * jp;
                    vtw[0][jp] = (v4[j].x & 0xffffu) | (v4[j + 1].x << 16); vtw[1][jp] = (v4[j].x >> 16) | (v4[j + 1].x & 0xffff0000u);
                    vtw[VPT - 2][jp] = (v4[j].y & 0xffffu) | (v4[j + 1].y << 16); vtw[VPT - 1][jp] = (v4[j].y >> 16) | (v4[j + 1].y & 0xffff0000u); }
            }
#pragma unroll
            for (int e = 0; e < VPT; ++e) *(LAS v4u*)(VT + (VPT * cp + e) * 72 + 8 * w) = (v4u){vtw[e][0], vtw[e][1], vtw[e][2], vtw[e][3]};
            if (w == 0) *(LAS f32x2*)(DEC + c0) = (f32x2){bend[0], bend[1]};
        }
        __syncthreads();
        if (c + 1 < SEQ / 64) MIX_LOAD(c + 1);
        {
            const int tt = w >> 1;
#pragma unroll
            for (int si = 0; si < 2; ++si) {
                const int st = 2 * (w & 1) + si;
                v2u o = (v2u){0u, 0u};
                if (st <= tt) {
                    f32x4 a = (f32x4){0.f, 0.f, 0.f, 0.f};
#pragma unroll
                    for (int ks = 0; ks < 4; ++ks) { const bf16x8 fa = *(const LAS bf16x8*)(KI + (16 * st + fr) * 136 + 32 * ks + 8 * fq); const bf16x8 fb = *(const LAS bf16x8*)(QD + (16 * tt + fr) * 136 + 32 * ks + 8 * fq); a = mfma16(fa, fb, a); }
                    const int tcol = 16 * tt + fr, s0 = 16 * st + 4 * fq;
                    const float m0 = (s0 + 0 <= tcol) ? a[0] : 0.f, m1 = (s0 + 1 <= tcol) ? a[1] : 0.f, m2 = (s0 + 2 <= tcol) ? a[2] : 0.f, m3 = (s0 + 3 <= tcol) ? a[3] : 0.f;
                    o.x = pk2(m0, m1); o.y = pk2(m2, m3);
                }
                *(LAS v2u*)(SC + (16 * tt + fr) * 72 + 16 * st + 4 * fq) = o;
            }
        }
        __syncthreads();
        v2u g4r[NVT][4];
#pragma unroll
        for (int tt = 0; tt < 4; ++tt)
#pragma unroll
            for (int vt = 0; vt < NVT; ++vt) g4r[vt][tt] = __builtin_nontemporal_load((const GAS v2u*)(hg + (size_t)(64 * c + 16 * tt + fr) * LDH + 16 * (NVT * w + vt) + 4 * fq));
        f32x4 oacc[NVT][4];
#pragma unroll
        for (int vt = 0; vt < NVT; ++vt) {
            const int vrow = 16 * (NVT * w + vt) + fr;
            bf16x8 sA[4];
#pragma unroll
            for (int j = 0; j < 4; ++j) { v4u t4; t4.x = pk2(Sacc[vt][2 * j][0], Sacc[vt][2 * j][1]); t4.y = pk2(Sacc[vt][2 * j][2], Sacc[vt][2 * j][3]); t4.z = pk2(Sacc[vt][2 * j + 1][0], Sacc[vt][2 * j + 1][1]); t4.w = pk2(Sacc[vt][2 * j + 1][2], Sacc[vt][2 * j + 1][3]); sA[j] = __builtin_bit_cast(bf16x8, t4); }
            bf16x8 vA[2];
#pragma unroll
            for (int ks = 0; ks < 2; ++ks) vA[ks] = *(const LAS bf16x8*)(VT + vrow * 72 + 32 * ks + 8 * fq);
#pragma unroll
            for (int tt = 0; tt < 4; ++tt) {
                f32x4 a = (f32x4){0.f, 0.f, 0.f, 0.f};
#pragma unroll
                for (int ks = 0; ks < 2; ++ks) { const bf16x8 fb = *(const LAS bf16x8*)(SC + (16 * tt + fr) * 72 + 32 * ks + 8 * fq); a = mfma16(vA[ks], fb, a); }
#pragma unroll
                for (int j = 0; j < 4; ++j) { const v2u b0 = *(const LAS v2u*)(QD + (16 * tt + fr) * 136 + 32 * j + 4 * fq), b1 = *(const LAS v2u*)(QD + (16 * tt + fr) * 136 + 32 * j + 16 + 4 * fq);
                    a = mfma16(sA[j], __builtin_bit_cast(bf16x8, (v4u){b0.x, b0.y, b1.x, b1.y}), a); }
                oacc[vt][tt] = a;
            }
#pragma unroll
            for (int dt = 0; dt < 8; ++dt) {
                const f32x4 dc = *(const LAS f32x4*)(DEC + 16 * dt + 4 * fq);
                f32x4 a = Sacc[vt][dt] * dc;
#pragma unroll
                for (int ks = 0; ks < 2; ++ks) { const bf16x8 fa = *(const LAS bf16x8*)(KE + (16 * dt + fr) * 72 + 32 * ks + 8 * fq); a = mfma16(fa, vA[ks], a); }
                Sacc[vt][dt] = a;
            }
        }
#pragma unroll
        for (int tt = 0; tt < 4; ++tt) { float s = 0.f;
#pragma unroll
            for (int vt = 0; vt < NVT; ++vt) s += (oacc[vt][tt][0] * oacc[vt][tt][0] + oacc[vt][tt][1] * oacc[vt][tt][1]) + (oacc[vt][tt][2] * oacc[vt][tt][2] + oacc[vt][tt][3] * oacc[vt][tt][3]);
            s += __shfl_xor(s, 16); s += __shfl_xor(s, 32);
            if (fq == 0) PART[w * 64 + 16 * tt + fr] = s; }
        __syncthreads();
#pragma unroll
        for (int tt = 0; tt < 4; ++tt) {
            float tot = 0.f;
#pragma unroll
            for (int ww = 0; ww < 8; ++ww) tot += PART[ww * 64 + 16 * tt + fr];
            const float rinv = __builtin_amdgcn_rsqf(tot * (1.f / DV) + NORM_EPS);
            const size_t tok = (size_t)(64 * c + 16 * tt + fr);
#pragma unroll
            for (int vt = 0; vt < NVT; ++vt) {
                const int col = 16 * (NVT * w + vt) + 4 * fq;
                const v2u g4 = g4r[vt][tt];
                const float g0 = bflo(g4.x), g1 = bfhi(g4.x), g2 = bflo(g4.y), g3 = bfhi(g4.y);
                const float y0 = oacc[vt][tt][0] * rinv * gn[vt][0] * (g0 * pg8::sigmoidf_(g0)), y1 = oacc[vt][tt][1] * rinv * gn[vt][1] * (g1 * pg8::sigmoidf_(g1));
                const float y2 = oacc[vt][tt][2] * rinv * gn[vt][2] * (g2 * pg8::sigmoidf_(g2)), y3 = oacc[vt][tt][3] * rinv * gn[vt][3] * (g3 * pg8::sigmoidf_(g3));
                v2u o; o.x = pk2(y0, y1); o.y = pk2(y2, y3);
                *(GAS v2u*)(Yb + tok * D + col) = o;
            }
        }
    }
#undef MIX_LOAD
    __syncthreads();
}

__global__ void __launch_bounds__(NWAVES * 64, 2) fwd_kernel(Args args) {
    extern __shared__ __attribute__((aligned(16))) unsigned char lds[];
    Frame F;
    F.lds = (LAS unsigned char*)lds;
    F.MISC = (volatile LAS unsigned*)(F.lds + MISC_OFF);
    F.tid = threadIdx.x; F.lane = F.tid & 63; F.wave = __builtin_amdgcn_readfirstlane(F.tid >> 6);
    F.G = gridDim.x; { const int bx = blockIdx.x; F.vcu = (F.G % 8 == 0) ? (bx % 8) * (F.G / 8) + bx / 8 : bx; }
    F.out = args.out; F.ws = args.ws;
    F.ctl = (gu32*)(args.ws + WS_CTL);
    for (int u = F.tid; u < (LDS_BYTES - LDSCTL_OFF) / 4; u += NWAVES * 64) ((LAS unsigned*)(F.lds + LDSCTL_OFF))[u] = 0u;
    __syncthreads();
    XcdBarrier bar; bar.bar = (unsigned*)(F.ctl + CW_BAR); bar.x = 0; bar.st = nullptr;
    if (N_LAUNCHES == 1) bar = xcd_barrier_post((unsigned*)(F.ctl + CW_BAR), F.MISC + 8);
#define GRID_BAR() do { if (N_LAUNCHES == 1) xcd_barrier(bar); } while (0)
    bool loc_ok = false;
    if (N_LAUNCHES == 1 && F.tid == 0) {
        const unsigned me = xb_xcc_id() + 1u, old = atomicCAS((unsigned*)(F.ctl + 8 + (blockIdx.x & 7)), 0u, me);
        if ((old != 0u && old != me) || F.G != 256) atomicAdd((unsigned*)(F.ctl + 2), 1u);
    }
#define XCD_BAR() do { if (N_LAUNCHES == 1) xcd_barrier(bar, loc_ok); } while (0)
    const int lo = args.ph_lo, hi = args.ph_hi;
#ifdef ONLY_PHASE
#define IN(k) ((k) == ONLY_PHASE && lo <= (k) && (k) < hi)
#else
#define IN(k) (lo <= (k) && (k) < hi)
#endif
#define BOTH(k) (IN(k) && IN((k) + 1))
    unsigned char* ws = args.ws;
    bf16* XB = (bf16*)(ws + WS_XB); bf16* HB = (bf16*)(ws + WS_H); bf16* YG = (bf16*)(ws + WS_YG); bf16* YC = (bf16*)(ws + WS_YCAT);
    bf16* Z = (bf16*)(ws + WS_Z); float* ST = (float*)(ws + WS_STATS);
    const int bid = blockIdx.x;

    if (IN(0)) { p0a_phase(F, args, true, F.vcu * NWAVES + F.wave, F.G * NWAVES, 0, NITEMS_EARLY); if (BOTH(0)) GRID_BAR(); }
    if (N_LAUNCHES == 1) loc_ok = (xb_ld((unsigned*)(F.ctl + 2)) == 0u) && F.MISC[8] == 32u && F.MISC[9] == 8u;
    if (IN(1)) { p0b_phase(F, args); if (BOTH(1)) XCD_BAR(); }
    if (IN(2)) {
        pg8::Gemm g{XB, (const bf16*)(ws + WS_W_IN0), M, N0, D}; pg8::StaticOrder S; S.init(M, N0, F.G, bid);
        pg8::EpiBf16 E{HB, N0};
        pg8::gemm_phase<pg8::EpiBf16, pg8::StaticOrder, PG8_ALIGN, PG8_SP2>(F.lds + RING_OFF, g, S, E);
        if (BOTH(2)) XCD_BAR();
    }
    if (IN(3)) {
        if (bid < 64) chunk_mixer_unit<0>(F, args, bid & 7, bid >> 3);
        else if (bid < 192) { s5_wave_unit(F, args, bid & 7, ((bid - 64) >> 3) * 8 + F.wave, F.lds + RING_OFF + F.wave * 12800);
            __syncthreads();
            p0a_phase(F, args, false, (bid - 64) * NWAVES + F.wave, 128 * NWAVES, NITEMS_EARLY, NITEMS_P3B); }
        else p0a_phase(F, args, false, (bid - 192) * NWAVES + F.wave, (F.G - 192) * NWAVES, NITEMS_P3B, NITEMS_P7);
        if (BOTH(3)) GRID_BAR();
    }
    if (IN(4)) {
        pg8::Gemm g{YG, (const bf16*)(ws + WS_W_GLU), M, S5W, S5W}; pg8::StaticOrder S; S.init(M, S5W, F.G, bid);
        pg8::EpiGlu E{YG, S5W, YC, D};
        pg8::gemm_phase<pg8::EpiGlu, pg8::StaticOrder, PG8_ALIGN, PG8_SP2>(F.lds + RING_OFF, g, S, E);
        if (BOTH(4)) XCD_BAR();
    }
    if (IN(5)) {
        pg8::Gemm g{YC, (const bf16*)(ws + WS_W_OUT0), M, D, D}; pg8::StaticOrder S; S.init(M, D, F.G, bid);
        pg8::EpiResT<false> E{args.in[I_X], Z, D, DN_ALPHA, nullptr, nullptr, nullptr};
        pg8::gemm_phase<pg8::EpiResT<false>, pg8::StaticOrder, PG8_ALIGN, PG8_SP2>(F.lds + RING_OFF, g, S, E);
        if (BOTH(5)) XCD_BAR();
    }
    if (IN(6)) { ln_phase(F, Z, args.in[I_LN_MIX_G], args.in[I_LN_MIX_B], nullptr, XB, ST); if (BOTH(6)) XCD_BAR(); }
    if (IN(7)) {
        pg8::Gemm g{XB, (const bf16*)(ws + WS_W_GU0), M, NGU, D}; pg8::StaticOrder S; S.init(M, NGU, F.G, bid);
        pg8::EpiSwiGlu E{HB, FF, HSLAB_EL};
        pg8::gemm_phase<pg8::EpiSwiGlu, pg8::StaticOrder, PG8_ALIGN, PG8_SP2>(F.lds + RING_OFF, g, S, E);
        if (bid >= 128) p0a_phase(F, args, false, (bid - 128) * NWAVES + F.wave, (F.G - 128) * NWAVES, NITEMS_P7, NITEMS_P14);
        if (BOTH(7)) XCD_BAR();
    }
    if (IN(8)) {
        pg8::Gemm g{HB, (const bf16*)(ws + WS_W_DN0), M, D, FF, HSLAB_EL * 2}; pg8::StaticOrder S; S.init(M, D, F.G, bid);
        pg8::EpiResT<true> E{nullptr, Z, D, DN_ALPHA, ST, args.in[I_LN_MIX_G], args.in[I_LN_MIX_B]};
        pg8::gemm_phase<pg8::EpiResT<true>, pg8::StaticOrder, PG8_ALIGN, PG8_SP2>(F.lds + RING_OFF, g, S, E);
        if (BOTH(8)) XCD_BAR();
    }
    if (IN(9)) { ln_phase(F, Z, args.in[I_LN_FFN_G], args.in[I_LN_FFN_B], nullptr, XB, ST); if (BOTH(9)) XCD_BAR(); }
    if (IN(10)) {
        pg8::Gemm g{XB, (const bf16*)(ws + WS_W_IN1), M, OD_IN, D}; pg8::StaticOrder S; S.init(M, OD_IN, F.G, bid);
        pg8::EpiBf16 E{HB, OD_IN};
        pg8::gemm_phase<pg8::EpiBf16, pg8::StaticOrder, PG8_ALIGN, PG8_SP2>(F.lds + RING_OFF, g, S, E);
        if (BOTH(10)) XCD_BAR();
    }
    if (IN(11)) { for (int u = bid; u < 256; u += F.G) chunk_mixer_unit<1>(F, args, u & 7, u >> 3); if (BOTH(11)) XCD_BAR(); }
    if (IN(12)) {
        pg8::Gemm g{YC, (const bf16*)(ws + WS_W_OUT1), M, D, D}; pg8::StaticOrder S; S.init(M, D, F.G, bid);
        pg8::EpiResT<true> E{nullptr, Z, D, DN_ALPHA, ST, args.in[I_LN_FFN_G], args.in[I_LN_FFN_B]};
        pg8::gemm_phase<pg8::EpiResT<true>, pg8::StaticOrder, PG8_ALIGN, PG8_SP2>(F.lds + RING_OFF, g, S, E);
        if (BOTH(12)) XCD_BAR();
    }
    if (IN(13)) { ln_phase(F, Z, args.in[I_LN_MIX_G] + D, args.in[I_LN_MIX_B] + D, nullptr, XB, ST); if (BOTH(13)) GRID_BAR(); }
    if (IN(14)) {
        pg8::Gemm g{XB, (const bf16*)(ws + WS_W_GU1), M, NGU, D}; pg8::StaticOrder S; S.init(M, NGU, F.G, bid);
        pg8::EpiSwiGlu E{HB, FF, HSLAB_EL};
        pg8::gemm_phase<pg8::EpiSwiGlu, pg8::StaticOrder, PG8_ALIGN, PG8_SP2>(F.lds + RING_OFF, g, S, E);
        if (bid >= 128) p0a_phase(F, args, false, (bid - 128) * NWAVES + F.wave, (F.G - 128) * NWAVES, NITEMS_P14, NITEMS);
        if (BOTH(14)) GRID_BAR();
    }
    if (IN(15)) {
        pg8::Gemm g{HB, (const bf16*)(ws + WS_W_DN1), M, D, FF, HSLAB_EL * 2}; pg8::StaticOrder S; S.init(M, D, F.G, bid);
        pg8::EpiResT<true> E{nullptr, Z, D, DN_ALPHA, ST, args.in[I_LN_MIX_G] + D, args.in[I_LN_MIX_B] + D};
        pg8::gemm_phase<pg8::EpiResT<true>, pg8::StaticOrder, PG8_ALIGN, PG8_SP2>(F.lds + RING_OFF, g, S, E);
        if (BOTH(15)) XCD_BAR();
    }
    if (IN(16)) { ln_phase(F, Z, args.in[I_LN_FFN_G] + D, args.in[I_LN_FFN_B] + D, F.out, nullptr, nullptr); }
#undef IN
#undef BOTH
}

extern "C" void kernel_launch(void* const* d_in, const int* in_sizes, int n_in, void* d_out, int out_size, void* d_ws, size_t ws_size, hipStream_t stream) {
    static int grid = 0;
    if (grid == 0) {
        if (n_in != 26 || in_sizes[0] != M * D || out_size != M * D || ws_size < WS_END) { fprintf(stderr, "kernel_launch: unexpected problem: n_in %d in0 %d out %d ws %zu (need %zu)\n", n_in, n_in > 0 ? in_sizes[0] : -1, out_size, ws_size, (size_t)WS_END); grid = -1; return; }
        if (hipFuncSetAttribute((const void*)fwd_kernel, hipFuncAttributeMaxDynamicSharedMemorySize, LDS_BYTES) != hipSuccess) { fprintf(stderr, "kernel_launch: hipFuncSetAttribute failed\n"); grid = -1; return; }
        int per_cu = 0;
        if (hipOccupancyMaxActiveBlocksPerMultiprocessor(&per_cu, (const void*)fwd_kernel, NWAVES * 64, LDS_BYTES) != hipSuccess || per_cu < 1)
            fprintf(stderr, "kernel_launch: note: occupancy query reports %d workgroups per CU\n", per_cu);
        (void)hipGetLastError();
        grid = 256;
    }
    if (grid < 0) return;
    if (hipMemsetAsync((char*)d_ws + WS_CTL, 0, CTL_ZERO_BYTES, stream) != hipSuccess) { fprintf(stderr, "kernel_launch: memset failed\n"); return; }
    Args a{};
    for (int i = 0; i < 26; ++i) a.in[i] = (const float*)d_in[i];
    a.out = (float*)d_out; a.ws = (unsigned char*)d_ws;
#ifndef PROBE_REPS
#define PROBE_REPS {1,1,1,1,1,1,1,1,1,1,1,1,1,1,1,1,1}
#endif
    static const int probe_reps[NPH] = PROBE_REPS;
    for (int li = 0; li < N_LAUNCHES; ++li) for (int rep = 0; rep < (N_LAUNCHES == 1 ? 1 : probe_reps[li]); ++rep) {
        a.ph_lo = (N_LAUNCHES == 1) ? 0 : li; a.ph_hi = (N_LAUNCHES == 1) ? NPH : li + 1; a.li = li; a.pad = 0;
        hipLaunchKernelGGL(fwd_kernel, dim3(grid), dim3(NWAVES * 64), LDS_BYTES, stream, a);
        const hipError_t le = hipPeekAtLastError();
        if (le != hipSuccess) { fprintf(stderr, "kernel_launch: launch %d failed: %s\n", li, hipGetErrorName(le)); break; }
    }
}
```

```cpp
#include <hip/hip_runtime.h>
#include <cstdio>
#include <cstdint>

#ifndef MK_N_LAUNCHES
#define MK_N_LAUNCHES 1
#endif

namespace pg8 {
#define PG8_LAS __attribute__((address_space(3)))
typedef unsigned short bf16_t;
typedef short bf16x8 __attribute__((ext_vector_type(8)));
typedef float f32x4 __attribute__((ext_vector_type(4)));
typedef unsigned u32x4 __attribute__((ext_vector_type(4)));
constexpr int BM = 256, BK = 64, HALF = 128, HTB = HALF * BK * 2, STAGE_BYTES = 8 * HTB, NXCD = 8, WGM = 8;

__host__ __device__ __forceinline__ int lds_byte(int r, int c) { const int st = (r >> 4) * 2 + (c >> 5), rr = r & 15, cc = c & 31, ob = rr * 64 + cc * 2; return st * 1024 + (ob ^ (((ob >> 9) & 1) << 5)); }
__host__ __device__ __forceinline__ void stage_rc(int b, int& R, int& C) { const int st = b / 1024, sb = b % 1024, swz = sb ^ (((sb >> 9) & 1) << 5); R = (st >> 1) * 16 + swz / 64; C = (st & 1) * 32 + (swz % 64) / 2; }
__host__ __device__ __forceinline__ int perm32(int rho) { const int n = rho >> 4, i = rho & 15; return 8 * (i >> 2) + 4 * n + (i & 3); }

struct Unit { int pm, pn; };
struct Gemm { const bf16_t* A; const bf16_t* Bt; int M, N, K; size_t bsA; };

struct StaticOrder {
    int nM, nN, nwg, G, c;
    __host__ __device__ void init(int M, int N, int G_, int c_) { nM = M / BM; nN = N / BM; nwg = nM * nN; G = G_; c = c_; }
    __host__ __device__ bool next(int i, Unit& u) const {
        const long L = (long)i * G + c; if (L >= nwg) return false;
        int wgid = (int)L; { const int q = nwg / NXCD, r = nwg % NXCD, xcd = wgid % NXCD, off = wgid / NXCD; wgid = (xcd < r ? xcd * (q + 1) : r * (q + 1) + (xcd - r) * q) + off; }
        const int nig = WGM * nN, gid = wgid / nig, fm = gid * WGM, gsz = (nM - fm) < WGM ? (nM - fm) : WGM;
        u.pm = fm + ((wgid % nig) % gsz); u.pn = (wgid % nig) / gsz; return true;
    }
    __device__ __forceinline__ void a_ready(const Unit&) const {}
    __device__ __forceinline__ void done(const Unit&) const {}
};

__device__ __forceinline__ unsigned cvt_pk_bf16(float lo, float hi) { unsigned r; asm volatile("v_cvt_pk_bf16_f32 %0, %1, %2" : "=v"(r) : "v"(lo), "v"(hi)); return r; }
__device__ __forceinline__ float bflo(unsigned x) { return __uint_as_float(x << 16); }
__device__ __forceinline__ float bfhi(unsigned x) { return __uint_as_float(x & 0xffff0000u); }
typedef _Float16 zh2 __attribute__((ext_vector_type(2)));
typedef float zf2 __attribute__((ext_vector_type(2)));
__device__ __forceinline__ unsigned pk_h2(float lo, float hi) { const zf2 f = {__builtin_fminf(__builtin_fmaxf(lo, -65504.f), 65504.f), __builtin_fminf(__builtin_fmaxf(hi, -65504.f), 65504.f)}; return __builtin_bit_cast(unsigned, __builtin_convertvector(f, zh2)); }
__device__ __forceinline__ float hflo(unsigned x) { return (float)__builtin_bit_cast(zh2, x).x; }
__device__ __forceinline__ float hfhi(unsigned x) { return (float)__builtin_bit_cast(zh2, x).y; }
__device__ __forceinline__ float sigmoidf_(float x) { return __builtin_amdgcn_rcpf(1.0f + __expf(-x)); }

struct EpiBf16 {
    static constexpr bool PERM = true, AFTER_DRAIN = false;
    bf16_t* O; int ldc;
    __device__ __forceinline__ void operator()(const f32x4 (&acc)[2][2][4][2], const Unit& u, int wr, int wc, int fr, int fq) const {
        const int row0 = u.pm * BM + wr * 64 + fr, col0 = u.pn * BM + wc * 32 + 8 * fq;
#pragma unroll
        for (int ai = 0; ai < 2; ++ai)
#pragma unroll
            for (int m = 0; m < 4; ++m) { bf16_t* rowp = O + (size_t)(row0 + ai * HALF + m * 16) * ldc + col0;
#pragma unroll
                for (int bj = 0; bj < 2; ++bj) { const f32x4 v0 = acc[ai][bj][m][0], v1 = acc[ai][bj][m][1];
                    u32x4 w; w.x = cvt_pk_bf16(v0[0], v0[1]); w.y = cvt_pk_bf16(v0[2], v0[3]); w.z = cvt_pk_bf16(v1[0], v1[1]); w.w = cvt_pk_bf16(v1[2], v1[3]);
                    *(u32x4*)(rowp + bj * HALF) = w; } }
    }
};
struct EpiGlu {
    static constexpr bool PERM = true, AFTER_DRAIN = false;
    const bf16_t* A; int lda; bf16_t* O; int ldc;
    __device__ __forceinline__ void operator()(const f32x4 (&acc)[2][2][4][2], const Unit& u, int wr, int wc, int fr, int fq) const {
        const int row0 = u.pm * BM + wr * 64 + fr, col0 = u.pn * BM + wc * 32 + 8 * fq;
#pragma unroll
        for (int ai = 0; ai < 2; ++ai) {
            u32x4 yv[4][2];
#pragma unroll
            for (int m = 0; m < 4; ++m)
#pragma unroll
                for (int bj = 0; bj < 2; ++bj) yv[m][bj] = *(const u32x4*)(A + (size_t)(row0 + ai * HALF + m * 16) * lda + col0 + bj * HALF);
#pragma unroll
            for (int m = 0; m < 4; ++m) { const size_t r = (size_t)(row0 + ai * HALF + m * 16);
#pragma unroll
                for (int bj = 0; bj < 2; ++bj) { const f32x4 v0 = acc[ai][bj][m][0], v1 = acc[ai][bj][m][1];
                    const u32x4 y = yv[m][bj];
                    u32x4 w;
                    w.x = cvt_pk_bf16(bflo(y.x) * sigmoidf_(v0[0]), bfhi(y.x) * sigmoidf_(v0[1]));
                    w.y = cvt_pk_bf16(bflo(y.y) * sigmoidf_(v0[2]), bfhi(y.y) * sigmoidf_(v0[3]));
                    w.z = cvt_pk_bf16(bflo(y.z) * sigmoidf_(v1[0]), bfhi(y.z) * sigmoidf_(v1[1]));
                    w.w = cvt_pk_bf16(bflo(y.w) * sigmoidf_(v1[2]), bfhi(y.w) * sigmoidf_(v1[3]));
                    *(u32x4*)(O + r * ldc + col0 + bj * HALF) = w; } }
            asm volatile("" ::: "memory"); }
    }
};
template <bool LNRES> struct EpiResT {
    static constexpr bool PERM = false, AFTER_DRAIN = false;
    const float* res; bf16_t* Z; int ldc; float alpha; const float* stats; const float* gam; const float* bet;
    __device__ __forceinline__ void operator()(const f32x4 (&acc)[2][2][4][2], const Unit& u, int wr, int wc, int fr, int fq) const {
        const int row0 = u.pm * BM + wr * 64 + fr, col0 = u.pn * BM + wc * 32 + 4 * fq;
        f32x4 gv[2][2], bv[2][2];
        if constexpr (LNRES) {
#pragma unroll
            for (int bj = 0; bj < 2; ++bj)
#pragma unroll
                for (int n = 0; n < 2; ++n) { gv[bj][n] = *(const f32x4*)(gam + col0 + bj * HALF + n * 16); bv[bj][n] = *(const f32x4*)(bet + col0 + bj * HALF + n * 16); }
        }
        if constexpr (LNRES) {
#pragma unroll
            for (int ai = 0; ai < 2; ++ai) {
                unsigned long long zr[4][2][2]; zf2 stv[4];
#pragma unroll
                for (int m = 0; m < 4; ++m) { const int row = row0 + ai * HALF + m * 16; const size_t off = (size_t)row * ldc + col0;
                    stv[m] = *(const zf2*)(stats + 2 * row);
#pragma unroll
                    for (int bj = 0; bj < 2; ++bj)
#pragma unroll
                        for (int n = 0; n < 2; ++n) zr[m][bj][n] = *(const unsigned long long*)(Z + off + bj * HALF + n * 16); }
                asm volatile("" ::: "memory");
#pragma unroll
                for (int m = 0; m < 4; ++m) { const size_t off = (size_t)(row0 + ai * HALF + m * 16) * ldc + col0; const float mu = stv[m].x, rsd = stv[m].y;
#pragma unroll
                    for (int bj = 0; bj < 2; ++bj)
#pragma unroll
                        for (int n = 0; n < 2; ++n) { const unsigned lo = (unsigned)zr[m][bj][n], hi = (unsigned)(zr[m][bj][n] >> 32);
                            f32x4 r = (f32x4){hflo(lo), hfhi(lo), hflo(hi), hfhi(hi)};
                            r = (r - mu) * rsd * gv[bj][n] + bv[bj][n];
                            const f32x4 zn = r * alpha + acc[ai][bj][m][n];
                            *(unsigned long long*)(Z + off + bj * HALF + n * 16) = ((unsigned long long)pk_h2(zn[2], zn[3]) << 32) | pk_h2(zn[0], zn[1]); } }
                asm volatile("" ::: "memory"); }
        } else {
#pragma unroll
        for (int ai = 0; ai < 2; ++ai)
#pragma unroll
            for (int mp = 0; mp < 4; mp += 2) {
                f32x4 rs[2][2][2];
#pragma unroll
                for (int mm = 0; mm < 2; ++mm) { const size_t off = (size_t)(row0 + ai * HALF + (mp + mm) * 16) * ldc + col0;
#pragma unroll
                    for (int bj = 0; bj < 2; ++bj)
#pragma unroll
                        for (int n = 0; n < 2; ++n) rs[mm][bj][n] = __builtin_nontemporal_load((const f32x4*)(res + off + bj * HALF + n * 16)); }
#pragma unroll
                for (int mm = 0; mm < 2; ++mm) { const size_t off = (size_t)(row0 + ai * HALF + (mp + mm) * 16) * ldc + col0;
#pragma unroll
                    for (int bj = 0; bj < 2; ++bj)
#pragma unroll
                        for (int n = 0; n < 2; ++n) { const f32x4 zn = rs[mm][bj][n] * alpha + acc[ai][bj][mp + mm][n];
                            *(unsigned long long*)(Z + off + bj * HALF + n * 16) = ((unsigned long long)pk_h2(zn[2], zn[3]) << 32) | pk_h2(zn[0], zn[1]); } }
                asm volatile("" ::: "memory"); }
        }
    }
};
struct EpiSwiGlu {
    static constexpr bool PERM = true, AFTER_DRAIN = false;
    bf16_t* O; int ldc; size_t bs;
    __device__ __forceinline__ void operator()(const f32x4 (&acc)[2][2][4][2], const Unit& u, int wr, int wc, int fr, int fq) const {
        const int row0 = u.pm * BM + wr * 64 + fr, col0 = u.pn * HALF + wc * 32 + 8 * fq;
        bf16_t* Ob = O + (size_t)(row0 >> 11) * bs + col0; const int lr0 = row0 & 2047;
#pragma unroll
        for (int ai = 0; ai < 2; ++ai)
#pragma unroll
            for (int m = 0; m < 4; ++m) { bf16_t* rowp = Ob + (size_t)(lr0 + ai * HALF + m * 16) * ldc;
                float o[8];
#pragma unroll
                for (int n = 0; n < 2; ++n)
#pragma unroll
                    for (int j = 0; j < 4; ++j) { const float g = acc[ai][0][m][n][j], up = acc[ai][1][m][n][j]; o[4 * n + j] = g * sigmoidf_(g) * up; }
                u32x4 w; w.x = cvt_pk_bf16(o[0], o[1]); w.y = cvt_pk_bf16(o[2], o[3]); w.z = cvt_pk_bf16(o[4], o[5]); w.w = cvt_pk_bf16(o[6], o[7]);
                *(u32x4*)rowp = w; }
    }
};

template <class Epi, class Sched, bool ALIGN_EPI = false, bool SP2 = false>
__device__ __forceinline__ void gemm_phase(PG8_LAS unsigned char* lds, const Gemm g, const Sched& S, const Epi& E) {
    const int tid = threadIdx.x, wid = __builtin_amdgcn_readfirstlane(tid >> 6), lane = tid & 63, wr = wid >> 2, wc = wid & 3, fr = lane & 15, fq = lane >> 4;
    const int K = g.K, nt = K / BK;
    unsigned voffA[2], voffB[2];
#pragma unroll
    for (int i = 0; i < 2; ++i) { int R, C; stage_rc(tid * 16 + i * 8192, R, C); const int Rb = Epi::PERM ? ((R & ~31) + perm32(R & 31)) : R;
        voffA[i] = (unsigned)(R * K + C) * 2u; voffB[i] = (unsigned)(Rb * K + C) * 2u; }
    const size_t kstep = (size_t)(BK * 2);
    const size_t hstep = (size_t)HALF * K * 2;
    const size_t tstep = 2 * hstep;
    const unsigned ldsw = (unsigned)wid * 1024u;
    const int aoff = lds_byte(wr * 64 + fr, fq * 8), boff = lds_byte(wc * 32 + fr, fq * 8);
#define PG8_SA(b, h) (((b) * 2 + (h)) * HTB)
#define PG8_SB(b, h) ((4 + (b) * 2 + (h)) * HTB)
#define PG8_STAGE(bufoff, gbase, voff) do { _Pragma("unroll") for (int _i = 0; _i < 2; ++_i) \
        __builtin_amdgcn_global_load_lds((const unsigned*)((const char*)(gbase) + (voff)[_i]), (PG8_LAS unsigned*)(lds + (bufoff) + ldsw + _i * 8192), 16, 0, 0); } while (0)
#define PG8_LDA(dst, b, h) do { _Pragma("unroll") for (int m = 0; m < 4; ++m) _Pragma("unroll") for (int k = 0; k < 2; ++k) dst[m][k] = *(const PG8_LAS bf16x8*)(lds + PG8_SA(b, h) + aoff + m * 2048 + k * 1024); } while (0)
#define PG8_LDB(dst, b, h) do { _Pragma("unroll") for (int n = 0; n < 2; ++n) _Pragma("unroll") for (int k = 0; k < 2; ++k) dst[n][k] = *(const PG8_LAS bf16x8*)(lds + PG8_SB(b, h) + boff + n * 2048 + k * 1024); } while (0)
#define PG8_MMA(ai, bj, At, Bt) do { __builtin_amdgcn_s_setprio(1); _Pragma("unroll") for (int m = 0; m < 4; ++m) _Pragma("unroll") for (int n = 0; n < 2; ++n) _Pragma("unroll") for (int k = 0; k < 2; ++k) \
        acc[ai][bj][m][n] = __builtin_amdgcn_mfma_f32_16x16x32_bf16(Bt[n][k], At[m][k], acc[ai][bj][m][n], 0, 0, 0); __builtin_amdgcn_s_setprio(0); } while (0)
#define PG8_WAIT_V(n) asm volatile("s_waitcnt vmcnt(" #n ")" ::: "memory")
#define PG8_WAIT_L(n) asm volatile("s_waitcnt lgkmcnt(" #n ")" ::: "memory")
#define PG8_BAR __builtin_amdgcn_s_barrier()
#define PG8_SCHED __builtin_amdgcn_sched_barrier(0)
    Unit cur, nxt; int ui = 0;
    if (!S.next(0, cur)) return;
    f32x4 acc[2][2][4][2];
#pragma unroll
    for (int a = 0; a < 2; ++a)
#pragma unroll
        for (int b = 0; b < 2; ++b)
#pragma unroll
            for (int m = 0; m < 4; ++m)
#pragma unroll
                for (int n = 0; n < 2; ++n) acc[a][b][m][n] = (f32x4){0.f, 0.f, 0.f, 0.f};
    bf16x8 At[4][2], B0[2][2], B1[2][2];
    auto abase = [&](int pm) -> size_t { return g.bsA ? (size_t)(pm >> 3) * g.bsA + (size_t)(pm & 7) * tstep : (size_t)pm * tstep; };
    const char* cA = (const char*)g.A + abase(cur.pm); const char* cB = (const char*)g.Bt + (size_t)cur.pn * tstep;
    S.a_ready(cur);
    if constexpr (SP2) {
        PG8_STAGE(PG8_SB(0, 0), cB, voffB); PG8_STAGE(PG8_SB(0, 1), cB + hstep, voffB); PG8_STAGE(PG8_SA(0, 0), cA, voffA); PG8_STAGE(PG8_SA(0, 1), cA + hstep, voffA);
        if (wr == 1) PG8_BAR;
        PG8_WAIT_V(2); PG8_BAR;
        PG8_STAGE(PG8_SB(1, 0), cB + kstep, voffB); PG8_STAGE(PG8_SA(1, 0), cA + kstep, voffA); PG8_STAGE(PG8_SB(1, 1), cB + hstep + kstep, voffB);
        PG8_WAIT_V(6); PG8_BAR;
    } else {
        PG8_STAGE(PG8_SB(0, 0), cB, voffB); PG8_STAGE(PG8_SA(0, 0), cA, voffA); PG8_STAGE(PG8_SB(0, 1), cB + hstep, voffB); PG8_STAGE(PG8_SA(0, 1), cA + hstep, voffA);
        if (wr == 1) PG8_BAR;
        PG8_WAIT_V(4); PG8_BAR;
        PG8_STAGE(PG8_SB(1, 0), cB + kstep, voffB); PG8_STAGE(PG8_SA(1, 0), cA + kstep, voffA); PG8_STAGE(PG8_SB(1, 1), cB + hstep + kstep, voffB);
        PG8_WAIT_V(6); PG8_BAR;
    }
    for (;;) {
        const bool has_next = S.next(ui + 1, nxt);
        const char* nA = has_next ? (const char*)g.A + abase(nxt.pm) : cA; const char* nB = has_next ? (const char*)g.Bt + (size_t)nxt.pn * tstep : cB;
        for (int t = 0; t < nt; t += 2) {
            const bool last = (t == nt - 2);
            const char* a1 = cA + (size_t)(t + 1) * kstep;
            const char* a2 = last ? nA : cA + (size_t)(t + 2) * kstep; const char* b2 = last ? nB : cB + (size_t)(t + 2) * kstep;
            const char* a3 = a2 + kstep; const char* b3 = b2 + kstep;
            if (last && has_next) S.a_ready(nxt);
            if constexpr (SP2) {
            PG8_LDB(B0, 0, 0); PG8_LDB(B1, 0, 1); PG8_SCHED; PG8_LDA(At, 0, 0); PG8_STAGE(PG8_SA(1, 1), a1 + hstep, voffA);
            PG8_WAIT_V(8); PG8_WAIT_L(0); PG8_BAR; PG8_MMA(0, 0, At, B0); PG8_MMA(0, 1, At, B1); PG8_BAR; PG8_SCHED;
            PG8_LDA(At, 0, 1); PG8_STAGE(PG8_SB(0, 0), b2, voffB); PG8_STAGE(PG8_SB(0, 1), b2 + hstep, voffB); PG8_STAGE(PG8_SA(0, 0), a2, voffA);
            PG8_WAIT_V(8); PG8_WAIT_L(0); PG8_BAR; PG8_MMA(1, 0, At, B0); PG8_MMA(1, 1, At, B1); PG8_BAR; PG8_SCHED;
            PG8_LDB(B0, 1, 0); PG8_LDB(B1, 1, 1); PG8_SCHED; PG8_LDA(At, 1, 0); PG8_STAGE(PG8_SA(0, 1), a2 + hstep, voffA);
            PG8_WAIT_V(8); PG8_WAIT_L(0); PG8_BAR; PG8_MMA(0, 0, At, B0); PG8_MMA(0, 1, At, B1); PG8_BAR; PG8_SCHED;
            PG8_LDA(At, 1, 1); PG8_STAGE(PG8_SB(1, 0), b3, voffB); PG8_STAGE(PG8_SB(1, 1), b3 + hstep, voffB); PG8_STAGE(PG8_SA(1, 0), a3, voffA);
            PG8_WAIT_V(8); PG8_WAIT_L(0); PG8_BAR; PG8_MMA(1, 0, At, B0); PG8_MMA(1, 1, At, B1); PG8_BAR; PG8_SCHED;
            } else {
            PG8_LDB(B0, 0, 0); PG8_SCHED; PG8_LDA(At, 0, 0); PG8_STAGE(PG8_SA(1, 1), a1 + hstep, voffA);
            PG8_WAIT_L(8); PG8_BAR; PG8_WAIT_L(0); PG8_MMA(0, 0, At, B0); PG8_BAR; PG8_SCHED;
            PG8_LDB(B1, 0, 1); PG8_STAGE(PG8_SB(0, 0), b2, voffB);
            PG8_BAR; PG8_WAIT_L(0); PG8_MMA(0, 1, At, B1); PG8_BAR;
            PG8_LDA(At, 0, 1); PG8_STAGE(PG8_SA(0, 0), a2, voffA);
            PG8_BAR; PG8_WAIT_L(0); PG8_MMA(1, 0, At, B0); PG8_BAR; PG8_SCHED;
            PG8_STAGE(PG8_SB(0, 1), b2 + hstep, voffB);
            PG8_WAIT_V(6); PG8_BAR; PG8_MMA(1, 1, At, B1); PG8_BAR;
            PG8_LDB(B0, 1, 0); PG8_SCHED; PG8_LDA(At, 1, 0); PG8_STAGE(PG8_SA(0, 1), a2 + hstep, voffA);
            PG8_WAIT_L(8); PG8_BAR; PG8_WAIT_L(0); PG8_MMA(0, 0, At, B0); PG8_BAR; PG8_SCHED;
            PG8_LDB(B1, 1, 1); PG8_STAGE(PG8_SB(1, 0), b3, voffB);
            PG8_BAR; PG8_WAIT_L(0); PG8_MMA(0, 1, At, B1); PG8_BAR;
            PG8_LDA(At, 1, 1); PG8_STAGE(PG8_SA(1, 0), a3, voffA);
            PG8_BAR; PG8_WAIT_L(0); PG8_MMA(1, 0, At, B0); PG8_BAR; PG8_SCHED;
            PG8_STAGE(PG8_SB(1, 1), b3 + hstep, voffB);
            PG8_WAIT_V(6); PG8_BAR; PG8_MMA(1, 1, At, B1); PG8_BAR;
            }
        }
        if constexpr (ALIGN_EPI) { if (wr == 0) PG8_BAR; }
        if constexpr (!Epi::AFTER_DRAIN) { E(acc, cur, wr, wc, fr, fq); S.done(cur); }
        if (!has_next) break;
#pragma unroll
        for (int a = 0; a < 2; ++a)
#pragma unroll
            for (int b = 0; b < 2; ++b)
#pragma unroll
                for (int m = 0; m < 4; ++m)
#pragma unroll
                    for (int n = 0; n < 2; ++n) acc[a][b][m][n] = (f32x4){0.f, 0.f, 0.f, 0.f};
        cur = nxt; cA = nA; cB = nB; ++ui;
        if constexpr (ALIGN_EPI) { if (wr == 1) PG8_BAR; }
    }
    PG8_WAIT_V(0);
    if constexpr (!ALIGN_EPI) { if (wr == 0) PG8_BAR; }
    PG8_BAR;
#undef PG8_SA
#undef PG8_SB
#undef PG8_STAGE
#undef PG8_LDA
#undef PG8_LDB
#undef PG8_MMA
#undef PG8_WAIT_V
#undef PG8_WAIT_L
#undef PG8_BAR
#undef PG8_SCHED
}
}

#ifndef PG8_SP2
#define PG8_SP2 true
#endif
#ifndef PG8_ALIGN
#define PG8_ALIGN true
#endif

constexpr int NWAVES = 8;
constexpr int NPH = 17;
constexpr int N_LAUNCHES = MK_N_LAUNCHES;
static_assert(N_LAUNCHES == 1 || N_LAUNCHES == NPH, "MK_N_LAUNCHES is 1 or NPH");

constexpr int D = 4096, SEQ = 2048, BATCH = 8, M = BATCH * SEQ;
constexpr int FF = 11008, NGU = 2 * FF;
constexpr int EV_IN = 8208, N0 = 8192, OD_IN = 16384;
constexpr int S5W = 2048, S5G = 128;
constexpr float DN_ALPHA = 1.41421356237f;
constexpr float NORM_EPS = 1e-5f;

constexpr size_t MiB = 1u << 20;
constexpr size_t WS_CTL = 0, CTL_ZERO_BYTES = 1 * MiB;
constexpr size_t WS_WAF = 1 * MiB;
constexpr size_t WS_AB = WS_WAF + 128 * 1024;
constexpr size_t WS_BBF = WS_AB + 64 * 1024;
constexpr size_t WS_CRF = WS_BBF + 1 * MiB;
constexpr size_t WS_STATS = 2 * MiB + 768 * 1024;
constexpr size_t WS_ALR = 3 * MiB;
constexpr size_t WS_W_IN0 = 4 * MiB, WS_W_GLU = 68 * MiB, WS_W_OUT0 = 76 * MiB, WS_W_GU0 = 108 * MiB, WS_W_DN0 = 280 * MiB;
constexpr size_t WS_W_IN1 = 366 * MiB, WS_W_OUT1 = 494 * MiB, WS_W_GU1 = 526 * MiB, WS_W_DN1 = 698 * MiB;
constexpr size_t WS_XB = 784 * MiB;
constexpr size_t WS_YCAT = WS_XB;
constexpr size_t WS_H = 912 * MiB;
constexpr size_t WS_Z = WS_H + 512 * MiB;
constexpr size_t WS_YG = WS_Z + 128 * MiB;
constexpr size_t HSLAB_EL = (size_t)32 * 1024 * 1024;
constexpr size_t WS_GDEC = WS_Z + 256 * MiB;
constexpr size_t WS_END = WS_GDEC + 64 * MiB;
static_assert(WS_CRF + 512 * 1024 <= WS_STATS && WS_STATS + 128 * 1024 <= WS_ALR, "tables");
static_assert(WS_W_GU0 + (size_t)NGU * D * 2 <= WS_W_DN0 && WS_W_DN0 + (size_t)D * FF * 2 <= WS_W_IN1 && WS_W_GU1 + (size_t)NGU * D * 2 <= WS_W_DN1 && WS_W_DN1 + (size_t)D * FF * 2 <= WS_XB, "weights");
static_assert(WS_H + (size_t)M * OD_IN * 2 <= WS_Z && WS_Z + (size_t)M * D * 4 <= WS_END, "h");

constexpr int CW_TMO = 0, CW_CODE = 1;
constexpr int CW_BAR = 4096;

constexpr int RING_OFF = 0, RING_BYTES = 131072;
constexpr int LDSCTL_OFF = RING_BYTES, MISC_OFF = LDSCTL_OFF + 320;
constexpr int LDS_BYTES = 147456;
static_assert(MISC_OFF + 128 <= LDS_BYTES, "LDS map");

#define GAS __attribute__((address_space(1)))
#define LAS __attribute__((address_space(3)))
typedef unsigned short bf16;
typedef unsigned v4u __attribute__((ext_vector_type(4)));
typedef unsigned v2u __attribute__((ext_vector_type(2)));
typedef float f32x4 __attribute__((ext_vector_type(4)));
typedef float f32x2 __attribute__((ext_vector_type(2)));
typedef short bf16x8 __attribute__((ext_vector_type(8)));
typedef GAS unsigned gu32;
#define RLX_AGENT __ATOMIC_RELAXED, __HIP_MEMORY_SCOPE_AGENT
#define LDS_WAIT() asm volatile("s_waitcnt lgkmcnt(0)" ::: "memory")
#define VM_WAIT() asm volatile("s_waitcnt vmcnt(0)" ::: "memory")
#define CFENCE() asm volatile("" ::: "memory")
__device__ __forceinline__ unsigned pk2(float lo, float hi) { return pg8::cvt_pk_bf16(lo, hi); }
__device__ __forceinline__ float bflo(unsigned x) { return __uint_as_float(x << 16); }
__device__ __forceinline__ float bfhi(unsigned x) { return __uint_as_float(x & 0xffff0000u); }
__device__ __forceinline__ f32x4 mfma16(bf16x8 a, bf16x8 b, f32x4 c) { return __builtin_amdgcn_mfma_f32_16x16x32_bf16(a, b, c, 0, 0, 0); }

#define XB_TMO      128
#define XB_XCNT(j)  (256  + 64 * (j))
#define XB_XSUB(j)  (1280 + 64 * (j))
#define XB_XGEN(j)  (2304 + 64 * (j))
#define XB_TOP      3328
#define XB_TOPGEN   3392
#define XCD_BAR_WORDS 3456
#define XB_SPIN_CAP (1u << 18)

__device__ __forceinline__ unsigned xb_ld(unsigned* p)              { return __hip_atomic_load(p, __ATOMIC_RELAXED, __HIP_MEMORY_SCOPE_AGENT); }
__device__ __forceinline__ unsigned xb_add(unsigned* p, unsigned v) { return __hip_atomic_fetch_add(p, v, __ATOMIC_RELAXED, __HIP_MEMORY_SCOPE_AGENT); }
__device__ __forceinline__ unsigned xb_xcc_id() { return (unsigned)__builtin_amdgcn_s_getreg((3 << 11) | 20) & 0xFu; }
#define XB_SPIN(cond, bar) do { unsigned _sp = 0; while (cond) { __builtin_amdgcn_s_sleep(1); \
    if ((++_sp & 255u) == 0u) { if (xb_ld(&(bar)[XB_TMO])) break; if (_sp > XB_SPIN_CAP) { atomicAdd(&(bar)[XB_TMO], 1u); break; } } } } while (0)

struct XcdBarrier {
    unsigned* bar; unsigned x;
    volatile LAS unsigned* st;
};
__device__ __forceinline__ XcdBarrier xcd_barrier_post(unsigned* bar, volatile LAS unsigned* st) {
    XcdBarrier b; b.bar = bar; b.x = xb_xcc_id(); b.st = st;
    if (threadIdx.x == 0) (void)xb_add(&bar[XB_XCNT(b.x)], 1u);
    return b;
}
__device__ __forceinline__ void xcd_barrier_complete(unsigned* bar, unsigned x, unsigned& nloc, unsigned& nx) {
    const unsigned G = gridDim.x * gridDim.y * gridDim.z;
    unsigned sum, cnt, mine, sp = 0u;
    for (;;) {
        sum = 0u; cnt = 0u; mine = 0u;
#pragma unroll
        for (unsigned j = 0; j < 16; ++j) { const unsigned c = xb_ld(&bar[XB_XCNT(j)]); sum += c; cnt += (c > 0u) ? 1u : 0u; mine = (j == x) ? c : mine; }
        if (sum == G) break;
        __builtin_amdgcn_s_sleep(1);
        if ((++sp & 255u) == 0u) { if (xb_ld(&bar[XB_TMO])) break; if (sp > XB_SPIN_CAP) { atomicAdd(&bar[XB_TMO], 1u); break; } }
    }
    nloc = mine > 0u ? mine : 1u; nx = cnt > 0u ? cnt : 1u;
}
__device__ __forceinline__ void xcd_barrier(const XcdBarrier& b, const bool local = false) {
    asm volatile("s_waitcnt vmcnt(0)" ::: "memory");
    __syncthreads();
    if (threadIdx.x == 0) {
        unsigned* bar = b.bar;
        __builtin_amdgcn_s_waitcnt(0);
        unsigned nloc = b.st[0], nx = b.st[1];
        if (nloc == 0u) { xcd_barrier_complete(bar, b.x, nloc, nx); b.st[0] = nloc; b.st[1] = nx; }
        const unsigned old = xb_add(&bar[XB_XSUB(b.x)], 1u);
        const unsigned gen = old / nloc;
        if (old + 1u == (gen + 1u) * nloc) {
            if (!local) {
                __builtin_amdgcn_fence(__ATOMIC_RELEASE, "agent");
                asm volatile("s_waitcnt vmcnt(0)" ::: "memory");
                const unsigned og = xb_add(&bar[XB_TOP], 1u);
                const unsigned tg = og / nx;
                if (og + 1u == (tg + 1u) * nx) xb_add(&bar[XB_TOPGEN], 1u);
                else XB_SPIN(xb_ld(&bar[XB_TOPGEN]) == tg, bar);
            }
            __builtin_amdgcn_fence(__ATOMIC_ACQUIRE, "agent");
            xb_add(&bar[XB_XGEN(b.x)], 1u);
            asm volatile("s_waitcnt vmcnt(0)" ::: "memory");
        } else {
            XB_SPIN(xb_ld(&bar[XB_XGEN(b.x)]) == gen, bar);
            __builtin_amdgcn_fence(__ATOMIC_ACQUIRE, "agent");
            asm volatile("s_waitcnt vmcnt(0)" ::: "memory");
        }
    }
    __syncthreads();
}

struct Args { const float* in[26]; float* out; unsigned char* ws; int ph_lo, ph_hi, li, pad; };
struct Frame {
    LAS unsigned char* lds;
    volatile LAS unsigned* MISC;
    gu32* ctl;
    int tid, lane, wave;
    int vcu, G;
    float* out;
    unsigned char* ws;
};
enum { I_X = 0, I_EV_W_IN, I_EV_W_OUT, I_S5_LAM_RE, I_S5_LAM_IM, I_S5_LOG_DT, I_S5_B_RE, I_S5_B_IM, I_S5_C_RE, I_S5_C_IM, I_S5_D, I_S5_W_GLU,
       I_GLA_W_ALPHA, I_GLA_B_ALPHA, I_GLA_NORM_G, I_OD_W_IN, I_OD_W_OUT, I_HG_LB, I_HG_NORM_G, I_LN_MIX_G, I_LN_MIX_B, I_LN_FFN_G, I_LN_FFN_B,
       I_FFN_W_GATE, I_FFN_W_UP, I_FFN_W_DOWN };

__device__ __forceinline__ float wave_sum(float v) {
#pragma unroll
    for (int o = 1; o < 64; o <<= 1) v += __shfl_xor(v, o);
    return v;
}

struct P0Item { const GAS float* src; size_t ldw; bf16* dst; size_t K8; };
__device__ __forceinline__ void p0_item_make(P0Item& d, const float* W, int K, int ldw, int nblk, bf16* WT, int mode, int item, int lane) {
    const int kb_ = item / nblk, nb = item - kb_ * nblk, k0 = 64 * kb_, n0 = 64 * nb;
    const int ng = lane & 15, kg = lane >> 4;
    d.src = (const GAS float*)W + (size_t)(k0 + 16 * kg) * ldw + n0 + 4 * ng; d.ldw = (size_t)ldw;
    const int rbase = (mode == 0) ? n0 : ((n0 >> 7) * 256 + (n0 & 127) + (mode == 2 ? 128 : 0));
    d.dst = WT + (size_t)(rbase + (lane >> 3)) * K + k0 + 8 * (lane & 7); d.K8 = (size_t)8 * K;
}
__device__ __forceinline__ void p0_item_load(const P0Item& d, f32x4 (&v)[2][8]) {
#pragma unroll
    for (int kb = 0; kb < 2; ++kb)
#pragma unroll
        for (int i = 0; i < 8; ++i) v[kb][i] = __builtin_nontemporal_load((const GAS f32x4*)(d.src + (size_t)(8 * kb + i) * d.ldw));
}
__device__ __forceinline__ void p0_item_finish(const P0Item& d, const f32x4 (&v)[2][8], LAS bf16* img, int lane) {
    const int ng = lane & 15, kg = lane >> 4;
#pragma unroll
    for (int kb = 0; kb < 2; ++kb)
#pragma unroll
        for (int j = 0; j < 4; ++j) {
            v4u o; o.x = pk2(v[kb][0][j], v[kb][1][j]); o.y = pk2(v[kb][2][j], v[kb][3][j]); o.z = pk2(v[kb][4][j], v[kb][5][j]); o.w = pk2(v[kb][6][j], v[kb][7][j]);
            *(LAS v4u*)(img + (4 * ng + j) * 72 + 16 * kg + 8 * kb) = o;
        }
    LDS_WAIT(); CFENCE();
#pragma unroll
    for (int j = 0; j < 8; ++j) { const int n = (lane >> 3) + 8 * j, c = lane & 7;
        const v4u o = *(const LAS v4u*)(img + n * 72 + 8 * c);
        *(GAS v4u*)(d.dst + (size_t)j * d.K8) = o; }
    LDS_WAIT(); CFENCE();
}

__device__ __forceinline__ void s5_disc(const Args& A, int g, int p, double& ar, double& ai, double& fr, double& fi) {
    const double dt = exp((double)A.in[I_S5_LOG_DT][g]);
    const double lr = (double)A.in[I_S5_LAM_RE][g * 64 + p], li = (double)A.in[I_S5_LAM_IM][g * 64 + p];
    const double mag = exp(lr * dt), th = li * dt;
    ar = mag * cos(th); ai = mag * sin(th);
    const double nr = ar - 1.0, ni = ai, den = lr * lr + li * li;
    fr = (nr * lr + ni * li) / den; fi = (ni * lr - nr * li) / den;
}

constexpr int IT_IN0 = (D / 64) * (N0 / 64), IT_GLU = (S5W / 64) * (S5W / 64), IT_OUT = (D / 64) * (D / 64), IT_G = (D / 64) * (FF / 64), IT_DN = (FF / 64) * (D / 64), IT_IN1 = (D / 64) * (OD_IN / 64);
constexpr int NITEMS = IT_IN0 + IT_GLU + 2 * IT_OUT + 4 * IT_G + 2 * IT_DN + IT_IN1;
constexpr int NITEMS_P14 = NITEMS - IT_DN;
constexpr int NITEMS_P7 = NITEMS_P14 - IT_G;
constexpr int NITEMS_P3B = NITEMS_P7 - IT_IN1 - IT_OUT - IT_DN;
constexpr int NITEMS_EARLY = NITEMS_P3B - IT_G;
__device__ __forceinline__ void p0a_phase(Frame& F, const Args& A, const bool tables, const int gw, const int NGW, const int it_lo, const int it_hi) {
    LAS bf16* scr = (LAS bf16*)(F.lds + RING_OFF + F.wave * 16384);
    if (tables) {
        const int gt = (F.vcu * NWAVES * 64) + F.tid;
        if (gt < 65536) {
            const int g = gt >> 9, n = (gt >> 6) & 7, l = gt & 63, q = l >> 4, pr = 16 * n + (l & 15);
            v4u o = (v4u){0u, 0u, 0u, 0u};
            if (q < 2) {
                const int p = pr & 63; double ar, ai, fr, fi; s5_disc(A, g, p, ar, ai, fr, fi);
                const float* bre = A.in[I_S5_B_RE] + ((size_t)g * 64 + p) * 16 + 8 * q; const float* bim = A.in[I_S5_B_IM] + ((size_t)g * 64 + p) * 16 + 8 * q;
                float v[8];
#pragma unroll
                for (int e = 0; e < 8; ++e) { const double br = bre[e], bi = bim[e]; v[e] = (float)((pr < 64) ? (fr * br - fi * bi) : (fr * bi + fi * br)); }
                o.x = pk2(v[0], v[1]); o.y = pk2(v[2], v[3]); o.z = pk2(v[4], v[5]); o.w = pk2(v[6], v[7]);
            }
            *(GAS v4u*)(F.ws + WS_BBF + (size_t)gt * 16) = o;
        } else if (gt < 65536 + 32768) {
            const int t = gt - 65536, g = t >> 8, ks = (t >> 6) & 3, l = t & 63, q = l >> 4, i = l & 15;
            float v[8];
#pragma unroll
            for (int e = 0; e < 8; ++e) { const int pp = 32 * ks + 8 * q + e; v[e] = (pp < 64) ? A.in[I_S5_C_RE][((size_t)g * 16 + i) * 64 + pp] : -A.in[I_S5_C_IM][((size_t)g * 16 + i) * 64 + (pp - 64)]; }
            v4u o; o.x = pk2(v[0], v[1]); o.y = pk2(v[2], v[3]); o.z = pk2(v[4], v[5]); o.w = pk2(v[6], v[7]);
            *(GAS v4u*)(F.ws + WS_CRF + (size_t)t * 16) = o;
        } else if (gt < 65536 + 32768 + 8192) {
            const int t = gt - 98304, g = t >> 6, p = t & 63; double ar, ai, fr, fi; s5_disc(A, g, p, ar, ai, fr, fi);
            *(GAS f32x2*)(F.ws + WS_AB + (size_t)t * 8) = (f32x2){(float)ar, (float)ai};
        } else if (gt < 65536 + 32768 + 8192 + 8192) {
            const int t = gt - 106496, ks = t >> 6, l = t & 63, q = l >> 4, n = l & 15;
            float v[8];
#pragma unroll
            for (int e = 0; e < 8; ++e) v[e] = A.in[I_EV_W_IN][(size_t)(32 * ks + 8 * q + e) * EV_IN + N0 + n];
            v4u o; o.x = pk2(v[0], v[1]); o.y = pk2(v[2], v[3]); o.z = pk2(v[4], v[5]); o.w = pk2(v[6], v[7]);
            *(GAS v4u*)(F.ws + WS_WAF + (size_t)t * 16) = o;
        }
    }
    auto decode = [&](int it, P0Item& d) {
        int r = it;
        if (r < IT_IN0) { p0_item_make(d, A.in[I_EV_W_IN], D, EV_IN, N0 / 64, (bf16*)(F.ws + WS_W_IN0), 0, r, F.lane); return; } r -= IT_IN0;
        if (r < IT_GLU) { p0_item_make(d, A.in[I_S5_W_GLU], S5W, S5W, S5W / 64, (bf16*)(F.ws + WS_W_GLU), 0, r, F.lane); return; } r -= IT_GLU;
        if (r < IT_OUT) { p0_item_make(d, A.in[I_EV_W_OUT], D, D, D / 64, (bf16*)(F.ws + WS_W_OUT0), 0, r, F.lane); return; } r -= IT_OUT;
        if (r < IT_G) { p0_item_make(d, A.in[I_FFN_W_GATE], D, FF, FF / 64, (bf16*)(F.ws + WS_W_GU0), 1, r, F.lane); return; } r -= IT_G;
        if (r < IT_G) { p0_item_make(d, A.in[I_FFN_W_UP], D, FF, FF / 64, (bf16*)(F.ws + WS_W_GU0), 2, r, F.lane); return; } r -= IT_G;
        if (r < IT_G) { p0_item_make(d, A.in[I_FFN_W_UP] + (size_t)D * FF, D, FF, FF / 64, (bf16*)(F.ws + WS_W_GU1), 2, r, F.lane); return; } r -= IT_G;
        if (r < IT_DN) { p0_item_make(d, A.in[I_FFN_W_DOWN], FF, D, D / 64, (bf16*)(F.ws + WS_W_DN0), 0, r, F.lane); return; } r -= IT_DN;
        if (r < IT_OUT) { p0_item_make(d, A.in[I_OD_W_OUT], D, D, D / 64, (bf16*)(F.ws + WS_W_OUT1), 0, r, F.lane); return; } r -= IT_OUT;
        if (r < IT_IN1) { p0_item_make(d, A.in[I_OD_W_IN], D, OD_IN, OD_IN / 64, (bf16*)(F.ws + WS_W_IN1), 0, r, F.lane); return; } r -= IT_IN1;
        if (r < IT_G) { p0_item_make(d, A.in[I_FFN_W_GATE] + (size_t)D * FF, D, FF, FF / 64, (bf16*)(F.ws + WS_W_GU1), 1, r, F.lane); return; } r -= IT_G;
        p0_item_make(d, A.in[I_FFN_W_DOWN] + (size_t)FF * D, FF, D, D / 64, (bf16*)(F.ws + WS_W_DN1), 0, r, F.lane);
    };
    int it = it_lo + gw;
    if (it < it_hi) {
        P0Item d0, d1, d2; f32x4 v0[2][8], v1[2][8], v2[2][8];
        decode(it, d0); p0_item_load(d0, v0);
        bool h1 = it + NGW < it_hi;
        if (h1) { decode(it + NGW, d1); p0_item_load(d1, v1); }
        for (;;) {
            bool h2 = h1 && (it + 2 * NGW < it_hi);
            if (h2) { decode(it + 2 * NGW, d2); p0_item_load(d2, v2); }
            p0_item_finish(d0, v0, scr, F.lane);
            if (!h1) break;
            it += NGW;
            bool h0 = h2 && (it + 2 * NGW < it_hi);
            if (h0) { decode(it + 2 * NGW, d0); p0_item_load(d0, v0); }
            p0_item_finish(d1, v1, scr, F.lane);
            if (!h2) break;
            it += NGW;
            h1 = h0 && (it + 2 * NGW < it_hi);
            if (h1) { decode(it + 2 * NGW, d1); p0_item_load(d1, v1); }
            p0_item_finish(d2, v2, scr, F.lane);
            if (!h0) break;
            it += NGW;
        }
    }
}

__device__ __forceinline__ void p0b_phase(Frame& F, const Args& A) {
    const int lane = F.lane, fr = lane & 15, fq = lane >> 4, w = F.wave;
    LAS float* red = (LAS float*)(F.lds + RING_OFF);
    const bf16* waf = (const bf16*)(F.ws + WS_WAF);
    bf16* XB = (bf16*)(F.ws + WS_XB);
    float* ALR = (float*)(F.ws + WS_ALR);
    float* GD = (float*)(F.ws + WS_GDEC);
    LAS float* alr_l = red + 1024;
    f32x2 wa[16];
#pragma unroll
    for (int r = 0; r < 16; ++r) wa[r] = *(const GAS f32x2*)(A.in[I_GLA_W_ALPHA] + r * 1024 + 2 * F.tid);
    const f32x2 ba2 = *(const GAS f32x2*)(A.in[I_GLA_B_ALPHA] + 2 * F.tid);
    for (int tb = F.vcu; tb < M / 64; tb += F.G) {
        const int row0 = 16 * (4 * tb + (w & 3)), kh = w >> 2;
        const float* xr = A.in[I_X] + (size_t)(row0 + fr) * D + 8 * fq;
        bf16* xo = XB + (size_t)(row0 + fr) * D + 8 * fq;
        f32x4 acc = (f32x4){0.f, 0.f, 0.f, 0.f};
#pragma unroll 4
        for (int ks = 64 * kh; ks < 64 * kh + 64; ++ks) {
            const f32x4 a0 = *(const GAS f32x4*)(xr + 32 * ks), a1 = *(const GAS f32x4*)(xr + 32 * ks + 4);
            v4u pa; pa.x = pk2(a0[0], a0[1]); pa.y = pk2(a0[2], a0[3]); pa.z = pk2(a1[0], a1[1]); pa.w = pk2(a1[2], a1[3]);
            *(GAS v4u*)(xo + 32 * ks) = pa;
            const v4u pb = *(const GAS v4u*)(waf + ((size_t)ks * 64 + lane) * 8);
            acc = mfma16(__builtin_bit_cast(bf16x8, pa), __builtin_bit_cast(bf16x8, pb), acc);
        }
        if (kh == 1) *(LAS f32x4*)(red + ((w & 3) * 64 + lane) * 4) = acc;
        __syncthreads();
        if (kh == 0) { const f32x4 o = acc + *(LAS f32x4*)(red + ((w & 3) * 64 + lane) * 4);
#pragma unroll
            for (int r = 0; r < 4; ++r) { ALR[(size_t)(row0 + 4 * fq + r) * 16 + fr] = o[r]; alr_l[(16 * (w & 3) + 4 * fq + r) * 16 + fr] = o[r]; } }
        __syncthreads();
        for (int t = 0; t < 64; ++t) {
            float z0 = ba2.x, z1 = ba2.y;
#pragma unroll
            for (int r4 = 0; r4 < 4; ++r4) { const f32x4 t4 = *(const LAS f32x4*)(alr_l + t * 16 + 4 * r4);
                z0 += t4.x * wa[4 * r4].x + t4.y * wa[4 * r4 + 1].x + t4.z * wa[4 * r4 + 2].x + t4.w * wa[4 * r4 + 3].x;
                z1 += t4.x * wa[4 * r4].y + t4.y * wa[4 * r4 + 1].y + t4.z * wa[4 * r4 + 2].y + t4.w * wa[4 * r4 + 3].y; }
            const float l0 = __log2f(1.f + __expf(-z0)), l1 = __log2f(1.f + __expf(-z1));
            *(GAS f32x2*)(GD + (size_t)(64 * tb + t) * 1024 + 2 * F.tid) = (f32x2){__builtin_amdgcn_exp2f(l0 * (-1.f / 16.f)), __builtin_amdgcn_exp2f(l1 * (-1.f / 16.f))};
        }
        __syncthreads();
    }
}

__device__ __forceinline__ void ln_phase(Frame& F, const bf16* z, const float* gam, const float* bet, float* outf, bf16* outb, float* stats) {
    const int RPW = M / (F.G * NWAVES), gw = (F.vcu * NWAVES + F.wave) * RPW, NGW = 1, MEND = gw + RPW;
    LAS float* gl = (LAS float*)(F.lds + RING_OFF); LAS float* bl = gl + D;
    for (int i = F.tid; i < D / 4; i += NWAVES * 64) { *(LAS f32x4*)(gl + 4 * i) = *(const GAS f32x4*)(gam + 4 * i); *(LAS f32x4*)(bl + 4 * i) = *(const GAS f32x4*)(bet + 4 * i); }
    __syncthreads();
    v4u pre[8];
    if (gw < M) { const GAS v4u* zr = (const GAS v4u*)(z + (size_t)gw * D) + F.lane;
#pragma unroll
        for (int j = 0; j < 8; ++j) pre[j] = zr[64 * j]; }
    for (int m = gw; m < MEND; m += NGW) {
        float v[8][8]; float s = 0.f;
#pragma unroll
        for (int j = 0; j < 8; ++j) { const v4u p = pre[j];
            v[j][0] = pg8::hflo(p.x); v[j][1] = pg8::hfhi(p.x); v[j][2] = pg8::hflo(p.y); v[j][3] = pg8::hfhi(p.y); v[j][4] = pg8::hflo(p.z); v[j][5] = pg8::hfhi(p.z); v[j][6] = pg8::hflo(p.w); v[j][7] = pg8::hfhi(p.w);
            s += ((v[j][0] + v[j][1]) + (v[j][2] + v[j][3])) + ((v[j][4] + v[j][5]) + (v[j][6] + v[j][7])); }
        if (m + NGW < MEND) { const GAS v4u* zn = (const GAS v4u*)(z + (size_t)(m + NGW) * D) + F.lane;
#pragma unroll
            for (int j = 0; j < 8; ++j) pre[j] = zn[64 * j]; }
        const float mean = wave_sum(s) * (1.f / D); float s2 = 0.f;
#pragma unroll
        for (int j = 0; j < 8; ++j)
#pragma unroll
            for (int e = 0; e < 8; ++e) { v[j][e] -= mean; s2 += v[j][e] * v[j][e]; }
        const float rstd = 1.f / sqrtf(wave_sum(s2) * (1.f / D) + NORM_EPS);
        if (stats && F.lane == 0) *(GAS f32x2*)(stats + 2 * m) = (f32x2){mean, rstd};
#pragma unroll
        for (int j = 0; j < 8; ++j) { const int e0 = 8 * (F.lane + 64 * j);
            const f32x4 g0 = *(const LAS f32x4*)(gl + e0), g1 = *(const LAS f32x4*)(gl + e0 + 4), b0 = *(const LAS f32x4*)(bl + e0), b1 = *(const LAS f32x4*)(bl + e0 + 4);
            const f32x4 o0 = (f32x4){v[j][0], v[j][1], v[j][2], v[j][3]} * rstd * g0 + b0, o1 = (f32x4){v[j][4], v[j][5], v[j][6], v[j][7]} * rstd * g1 + b1;
            if (outf) { *(GAS f32x4*)(outf + (size_t)m * D + e0) = o0; *(GAS f32x4*)(outf + (size_t)m * D + e0 + 4) = o1; }
            if (outb) { v4u pb; pb.x = pk2(o0.x, o0.y); pb.y = pk2(o0.z, o0.w); pb.z = pk2(o1.x, o1.y); pb.w = pk2(o1.z, o1.w); *(GAS v4u*)(outb + (size_t)m * D + e0) = pb; } }
    }
    __syncthreads();
}

__device__ __forceinline__ float gelu_tanh(float y) {
    const float a = 0.7978845608028654f * (y + 0.044715f * y * y * y);
    const float e = __expf(2.f * a);
    const float th = 1.f - 2.f * __builtin_amdgcn_rcpf(1.f + e);
    return 0.5f * y * (1.f + th);
}
__device__ __forceinline__ void s5_wave_unit(Frame& F, const Args& A, int b, int g, LAS unsigned char* wl) {
    const int lane = F.lane, fr = lane & 15, fq = lane >> 4;
    LAS float* BUl = (LAS float*)wl;
    LAS bf16* Xl = (LAS bf16*)(wl + 16 * 132 * 4);
    bf16x8 bbA[8], crA[4];
#pragma unroll
    for (int n = 0; n < 8; ++n) bbA[n] = __builtin_bit_cast(bf16x8, *(const GAS v4u*)(F.ws + WS_BBF + ((size_t)(g * 8 + n) * 64 + lane) * 16));
#pragma unroll
    for (int k = 0; k < 4; ++k) crA[k] = __builtin_bit_cast(bf16x8, *(const GAS v4u*)(F.ws + WS_CRF + ((size_t)(g * 4 + k) * 64 + lane) * 16));
    const f32x2 ab = *(const GAS f32x2*)(F.ws + WS_AB + ((size_t)g * 64 + lane) * 8);
    const float ar = ab.x, ai = ab.y;
    float dsk[4];
#pragma unroll
    for (int r = 0; r < 4; ++r) dsk[r] = A.in[I_S5_D][16 * g + 4 * fq + r];
    float xr = 0.f, xi = 0.f;
    const bf16* up = (const bf16*)(F.ws + WS_H) + (size_t)(b * SEQ) * N0 + 16 * g;
    bf16* yp = (bf16*)(F.ws + WS_YG) + (size_t)(b * SEQ) * S5W + 16 * g;
    v4u ub = (v4u){0u, 0u, 0u, 0u};
    if (fq < 2) ub = *(const GAS v4u*)(up + (size_t)fr * N0 + 8 * fq);
    for (int blk = 0; blk < SEQ / 16; ++blk) {
        const int tok0 = 16 * blk;
        const bf16x8 ubf = __builtin_bit_cast(bf16x8, ub);
        const v2u u4 = *(const GAS v2u*)(up + (size_t)(tok0 + fr) * N0 + 4 * fq);
        v4u ubn = (v4u){0u, 0u, 0u, 0u};
        if (fq < 2 && blk + 1 < SEQ / 16) ubn = *(const GAS v4u*)(up + (size_t)(tok0 + 16 + fr) * N0 + 8 * fq);
#pragma unroll
        for (int n = 0; n < 8; ++n) { const f32x4 d = mfma16(bbA[n], ubf, (f32x4){0.f, 0.f, 0.f, 0.f}); *(LAS f32x4*)(BUl + fr * 132 + 16 * n + 4 * fq) = d; }
        CFENCE();
#pragma unroll
        for (int t = 0; t < 16; ++t) {
            const float bre = BUl[t * 132 + lane], bim = BUl[t * 132 + 64 + lane];
            const float nxr = ar * xr - ai * xi + bre, nxi = ar * xi + ai * xr + bim; xr = nxr; xi = nxi;
            Xl[t * 136 + lane] = (bf16)(pk2(xr, 0.f) & 0xffffu); Xl[t * 136 + 64 + lane] = (bf16)(pk2(xi, 0.f) & 0xffffu);
        }
        CFENCE();
        f32x4 acc = (f32x4){0.f, 0.f, 0.f, 0.f};
#pragma unroll
        for (int k = 0; k < 4; ++k) { const bf16x8 bx = *(const LAS bf16x8*)(Xl + fr * 136 + 32 * k + 8 * fq); acc = mfma16(crA[k], bx, acc); }
        CFENCE();
        const float u0 = bflo(u4.x), u1 = bfhi(u4.x), u2 = bflo(u4.y), u3 = bfhi(u4.y);
        const float y0 = gelu_tanh(acc[0] + dsk[0] * u0), y1 = gelu_tanh(acc[1] + dsk[1] * u1), y2 = gelu_tanh(acc[2] + dsk[2] * u2), y3 = gelu_tanh(acc[3] + dsk[3] * u3);
        v2u o; o.x = pk2(y0, y1); o.y = pk2(y2, y3);
        *(GAS v2u*)(yp + (size_t)(tok0 + fr) * S5W + 4 * fq) = o;
        ub = ubn;
    }
}

template <int MODE>
__device__ __forceinline__ void chunk_mixer_unit(Frame& F, const Args& A, int b, int h) {
    constexpr int NVT = MODE == 0 ? 2 : 1, DV = 128 * NVT;
    constexpr int LDH = MODE == 0 ? N0 : OD_IN;
    constexpr int QCOL = MODE == 0 ? 2048 : 0, KCOL = MODE == 0 ? 3072 : 4096, VCOL = MODE == 0 ? 4096 : 8192, GCOL = MODE == 0 ? 6144 : 12288, YCOL = MODE == 0 ? 2048 : 0;
    constexpr int VPT = MODE == 0 ? 4 : 2;
    LAS unsigned char* L = F.lds;
    LAS bf16* QD = (LAS bf16*)(L + 0);
    LAS bf16* KI = (LAS bf16*)(L + 17408);
    LAS bf16* KE = (LAS bf16*)(L + 34816);
    LAS bf16* SC = (LAS bf16*)(L + 53248);
    LAS float* DEC = (LAS float*)(L + 62464);
    LAS float* XCH = (LAS float*)(L + 62976);
    LAS float* PART = (LAS float*)(L + 67072);
    LAS bf16* VT = (LAS bf16*)(L + 69120);
    const int tid = F.tid, lane = F.lane, w = tid >> 6, cp = lane, fr = lane & 15, fq = lane >> 4, c0 = 2 * cp;
    const bf16* Hb = (const bf16*)(F.ws + WS_H) + (size_t)(b * SEQ) * LDH;
    bf16* Yb = (bf16*)(F.ws + WS_YCAT) + (size_t)(b * SEQ) * D + YCOL + h * DV;
    const bf16* hq = Hb + QCOL + h * 128 + c0;
    const bf16* hk = Hb + KCOL + h * 128 + c0;
    const bf16* hv = Hb + VCOL + h * DV + VPT * cp;
    const bf16* hg = Hb + GCOL + h * DV;
    float lb[2], ba[2];
    if constexpr (MODE == 1) {
#pragma unroll
        for (int e = 0; e < 2; ++e) { const float t0 = A.in[I_HG_LB][h * 128 + c0 + e], t1 = A.in[I_HG_LB][D + h * 128 + c0 + e]; lb[e] = 1.f / (1.f + __expf(t0 - t1)); }
    } else {
#pragma unroll
        for (int e = 0; e < 2; ++e) ba[e] = A.in[I_GLA_B_ALPHA][h * 128 + c0 + e];
    }
    float gn[NVT][4];
#pragma unroll
    for (int vt = 0; vt < NVT; ++vt)
#pragma unroll
        for (int r = 0; r < 4; ++r) gn[vt][r] = (MODE == 0 ? A.in[I_GLA_NORM_G] : A.in[I_HG_NORM_G])[16 * (NVT * w + vt) + 4 * fq + r];
    f32x4 Sacc[NVT][8];
#pragma unroll
    for (int vt = 0; vt < NVT; ++vt)
#pragma unroll
        for (int dt = 0; dt < 8; ++dt) Sacc[vt][dt] = (f32x4){0.f, 0.f, 0.f, 0.f};
    unsigned q2[8], k2[8]; v2u v4[8]; f32x2 dcv[8];
    const float* gdp = (const float*)(F.ws + WS_GDEC) + (size_t)(b * SEQ + 8 * w) * 1024 + h * 128 + c0;
#define MIX_LOAD(c) do { _Pragma("unroll") for (int j = 0; j < 8; ++j) { const size_t ro = (size_t)(64 * (c) + 8 * w + j) * LDH; \
        q2[j] = *(const GAS unsigned*)(hq + ro); k2[j] = *(const GAS unsigned*)(hk + ro); \
        if (MODE == 0) dcv[j] = *(const GAS f32x2*)(gdp + (size_t)(64 * (c) + j) * 1024); \
        if (MODE == 0) v4[j] = *(const GAS v2u*)(hv + ro); else { v4[j].x = *(const GAS unsigned*)(hv + ro); v4[j].y = 0u; } } } while (0)
    MIX_LOAD(0);
    for (int c = 0; c < SEQ / 64; ++c) {
        float kk[8][2], cs[8][2];
        unsigned vtw[VPT][4];
        if constexpr (MODE == 1) {
            float vv[8][2];
#pragma unroll
            for (int j = 0; j < 8; ++j)
#pragma unroll
                for (int e = 0; e < 2; ++e) {
                    const float fl = e ? bfhi(k2[j]) : bflo(k2[j]);
                    const float tt = __expf(-fl), sg = __builtin_amdgcn_rcpf(1.f + tt);
                    const float f = lb[e] + (1.f - lb[e]) * sg;
                    cs[j][e] = f; kk[j][e] = (1.f - lb[e]) * (tt * sg);
                    const float iv = e ? bfhi(v4[j].x) : bflo(v4[j].x);
                    vv[j][e] = iv * __builtin_amdgcn_rcpf(1.f + __expf(-iv));
                }
#pragma unroll
            for (int jp = 0; jp < 4; ++jp) { vtw[0][jp] = pk2(vv[2 * jp][0], vv[2 * jp + 1][0]); vtw[1][jp] = pk2(vv[2 * jp][1], vv[2 * jp + 1][1]); }
        } else {
#pragma unroll
            for (int j = 0; j < 8; ++j) { cs[j][0] = dcv[j].x; cs[j][1] = dcv[j].y; }
        }
#pragma unroll
        for (int j = 1; j < 8; ++j) { cs[j][0] *= cs[j - 1][0]; cs[j][1] *= cs[j - 1][1]; }
        *(LAS f32x2*)(XCH + w * 128 + c0) = (f32x2){cs[7][0], cs[7][1]};
        __syncthreads();
        float off[2] = {1.f, 1.f}, bend[2] = {1.f, 1.f};
#pragma unroll
        for (int ww = 0; ww < 8; ++ww) { const f32x2 t2 = *(const LAS f32x2*)(XCH + ww * 128 + c0); if (ww < w) { off[0] *= t2.x; off[1] *= t2.y; } bend[0] *= t2.x; bend[1] *= t2.y; }
        {
            unsigned ke[2][4];
#pragma unroll
            for (int j = 0; j < 8; j += 2) {
                float qd[2][2], ki[2][2], kev[2][2];
#pragma unroll
                for (int jj = 0; jj < 2; ++jj)
#pragma unroll
                    for (int e = 0; e < 2; ++e) { const float pq = cs[j + jj][e] * off[e];
                        const float qv = (e ? bfhi(q2[j + jj]) : bflo(q2[j + jj])) * (MODE == 0 ? 0.08838834764831845f : 1.f);
                        const float kv_ = (MODE == 1) ? kk[j + jj][e] : (e ? bfhi(k2[j + jj]) : bflo(k2[j + jj]));
                        qd[jj][e] = qv * pq; ki[jj][e] = kv_ * __builtin_amdgcn_rcpf(pq); kev[jj][e] = ki[jj][e] * bend[e]; }
                *(LAS unsigned*)(QD + (8 * w + j) * 136 + c0) = pk2(qd[0][0], qd[0][1]); *(LAS unsigned*)(QD + (8 * w + j + 1) * 136 + c0) = pk2(qd[1][0], qd[1][1]);
                *(LAS unsigned*)(KI + (8 * w + j) * 136 + c0) = pk2(ki[0][0], ki[0][1]); *(LAS unsigned*)(KI + (8 * w + j + 1) * 136 + c0) = pk2(ki[1][0], ki[1][1]);
                ke[0][j >> 1] = pk2(kev[0][0], kev[1][0]); ke[1][j >> 1] = pk2(kev[0][1], kev[1][1]);
            }
#pragma unroll
            for (int e = 0; e < 2; ++e) *(LAS v4u*)(KE + (c0 + e) * 72 + 8 * w) = (v4u){ke[e][0], ke[e][1], ke[e][2], ke[e][3]};
            if constexpr (MODE == 0) {
#pragma unroll
                for (int jp = 0; jp < 4; ++jp) { const int j = 2 * jp;
                    vtw[0][jp] = (v4[j].x & 0xffffu) | (v4[j + 1].x << 16); vtw[1][jp] = (v4[j].x >> 16) | (v4[j + 1].x & 0xffff0000u);
                    vtw[VPT - 2][jp] = (v4[j].y & 0xffffu) | (v4[j + 1].y << 16); vtw[VPT - 1][jp] = (v4[j].y >> 16) | (v4[j + 1].y & 0xffff0000u); }
            }
#pragma unroll
            for (int e = 0; e < VPT; ++e) *(LAS v4u*)(VT + (VPT * cp + e) * 72 + 8 * w) = (v4u){vtw[e][0], vtw[e][1], vtw[e][2], vtw[e][3]};
            if (w == 0) *(LAS f32x2*)(DEC + c0) = (f32x2){bend[0], bend[1]};
        }
        __syncthreads();
        if (c + 1 < SEQ / 64) MIX_LOAD(c + 1);
        {
            const int tt = w >> 1;
#pragma unroll
            for (int si = 0; si < 2; ++si) {
                const int st = 2 * (w & 1) + si;
                v2u o = (v2u){0u, 0u};
                if (st <= tt) {
                    f32x4 a = (f32x4){0.f, 0.f, 0.f, 0.f};
#pragma unroll
                    for (int ks = 0; ks < 4; ++ks) { const bf16x8 fa = *(const LAS bf16x8*)(KI + (16 * st + fr) * 136 + 32 * ks + 8 * fq); const bf16x8 fb = *(const LAS bf16x8*)(QD + (16 * tt + fr) * 136 + 32 * ks + 8 * fq); a = mfma16(fa, fb, a); }
                    const int tcol = 16 * tt + fr, s0 = 16 * st + 4 * fq;
                    const float m0 = (s0 + 0 <= tcol) ? a[0] : 0.f, m1 = (s0 + 1 <= tcol) ? a[1] : 0.f, m2 = (s0 + 2 <= tcol) ? a[2] : 0.f, m3 = (s0 + 3 <= tcol) ? a[3] : 0.f;
                    o.x = pk2(m0, m1); o.y = pk2(m2, m3);
                }
                *(LAS v2u*)(SC + (16 * tt + fr) * 72 + 16 * st + 4 * fq) = o;
            }
        }
        __syncthreads();
        v2u g4r[NVT][4];
#pragma unroll
        for (int tt = 0; tt < 4; ++tt)
#pragma unroll
            for (int vt = 0; vt < NVT; ++vt) g4r[vt][tt] = *(const GAS v2u*)(hg + (size_t)(64 * c + 16 * tt + fr) * LDH + 16 * (NVT * w + vt) + 4 * fq);
        f32x4 oacc[NVT][4];
#pragma unroll
        for (int vt = 0; vt < NVT; ++vt) {
            const int vrow = 16 * (NVT * w + vt) + fr;
            bf16x8 sA[4];
#pragma unroll
            for (int j = 0; j < 4; ++j) { v4u t4; t4.x = pk2(Sacc[vt][2 * j][0], Sacc[vt][2 * j][1]); t4.y = pk2(Sacc[vt][2 * j][2], Sacc[vt][2 * j][3]); t4.z = pk2(Sacc[vt][2 * j + 1][0], Sacc[vt][2 * j + 1][1]); t4.w = pk2(Sacc[vt][2 * j + 1][2], Sacc[vt][2 * j + 1][3]); sA[j] = __builtin_bit_cast(bf16x8, t4); }
            bf16x8 vA[2];
#pragma unroll
            for (int ks = 0; ks < 2; ++ks) vA[ks] = *(const LAS bf16x8*)(VT + vrow * 72 + 32 * ks + 8 * fq);
#pragma unroll
            for (int tt = 0; tt < 4; ++tt) {
                f32x4 a = (f32x4){0.f, 0.f, 0.f, 0.f};
#pragma unroll
                for (int ks = 0; ks < 2; ++ks) { const bf16x8 fb = *(const LAS bf16x8*)(SC + (16 * tt + fr) * 72 + 32 * ks + 8 * fq); a = mfma16(vA[ks], fb, a); }
#pragma unroll
                for (int j = 0; j < 4; ++j) { const v2u b0 = *(const LAS v2u*)(QD + (16 * tt + fr) * 136 + 32 * j + 4 * fq), b1 = *(const LAS v2u*)(QD + (16 * tt + fr) * 136 + 32 * j + 16 + 4 * fq);
                    a = mfma16(sA[j], __builtin_bit_cast(bf16x8, (v4u){b0.x, b0.y, b1.x, b1.y}), a); }
                oacc[vt][tt] = a;
            }
#pragma unroll
            for (int dt = 0; dt < 8; ++dt) {
                const f32x4 dc = *(const LAS f32x4*)(DEC + 16 * dt + 4 * fq);
                f32x4 a = Sacc[vt][dt] * dc;
#pragma unroll
                for (int ks = 0; ks < 2; ++ks) { const bf16x8 fa = *(const LAS bf16x8*)(KE + (16 * dt + fr) * 72 + 32 * ks + 8 * fq); a = mfma16(fa, vA[ks], a); }
                Sacc[vt][dt] = a;
            }
        }
#pragma unroll
        for (int tt = 0; tt < 4; ++tt) { float s = 0.f;
#pragma unroll
            for (int vt = 0; vt < NVT; ++vt) s += (oacc[vt][tt][0] * oacc[vt][tt][0] + oacc[vt][tt][1] * oacc[vt][tt][1]) + (oacc[vt][tt][2] * oacc[vt][tt][2] + oacc[vt][tt][3] * oacc[vt][tt][3]);
            s += __shfl_xor(s, 16); s += __shfl_xor(s, 32);
            if (fq == 0) PART[w * 64 + 16 * tt + fr] = s; }
        __syncthreads();
#pragma unroll
        for (int tt = 0; tt < 4; ++tt) {
            float tot = 0.f;
#pragma unroll
            for (int ww = 0; ww < 8; ++ww) tot += PART[ww * 64 + 16 * tt + fr];
            const float rinv = __builtin_amdgcn_rsqf(tot * (1.f / DV) + NORM_EPS);
            const size_t tok = (size_t)(64 * c + 16 * tt + fr);
#pragma unroll
            for (int vt = 0; vt < NVT; ++vt) {
                const int col = 16 * (NVT * w + vt) + 4 * fq;
                const v2u g4 = g4r[vt][tt];
                const float g0 = bflo(g4.x), g1 = bfhi(g4.x), g2 = bflo(g4.y), g3 = bfhi(g4.y);
                const float y0 = oacc[vt][tt][0] * rinv * gn[vt][0] * (g0 * pg8::sigmoidf_(g0)), y1 = oacc[vt][tt][1] * rinv * gn[vt][1] * (g1 * pg8::sigmoidf_(g1));
                const float y2 = oacc[vt][tt][2] * rinv * gn[vt][2] * (g2 * pg8::sigmoidf_(g2)), y3 = oacc[vt][tt][3] * rinv * gn[vt][3] * (g3 * pg8::sigmoidf_(g3));
                v2u o; o.x = pk2(y0, y1); o.y = pk2(y2, y3);
                *(GAS v2u*)(Yb + tok * D + col) = o;
            }
        }
    }
#undef MIX_LOAD
    __syncthreads();
}

__global__ void __launch_bounds__(NWAVES * 64, 2) fwd_kernel(Args args) {
    extern __shared__ __attribute__((aligned(16))) unsigned char lds[];
    Frame F;
    F.lds = (LAS unsigned char*)lds;
    F.MISC = (volatile LAS unsigned*)(F.lds + MISC_OFF);
    F.tid = threadIdx.x; F.lane = F.tid & 63; F.wave = __builtin_amdgcn_readfirstlane(F.tid >> 6);
    F.G = gridDim.x; { const int bx = blockIdx.x; F.vcu = (F.G % 8 == 0) ? (bx % 8) * (F.G / 8) + bx / 8 : bx; }
    F.out = args.out; F.ws = args.ws;
    F.ctl = (gu32*)(args.ws + WS_CTL);
    for (int u = F.tid; u < (LDS_BYTES - LDSCTL_OFF) / 4; u += NWAVES * 64) ((LAS unsigned*)(F.lds + LDSCTL_OFF))[u] = 0u;
    __syncthreads();
    XcdBarrier bar; bar.bar = (unsigned*)(F.ctl + CW_BAR); bar.x = 0; bar.st = nullptr;
    if (N_LAUNCHES == 1) bar = xcd_barrier_post((unsigned*)(F.ctl + CW_BAR), F.MISC + 8);
#define GRID_BAR() do { if (N_LAUNCHES == 1) xcd_barrier(bar); } while (0)
    bool loc_ok = false;
    if (N_LAUNCHES == 1 && F.tid == 0) {
        const unsigned me = xb_xcc_id() + 1u, old = atomicCAS((unsigned*)(F.ctl + 8 + (blockIdx.x & 7)), 0u, me);
        if ((old != 0u && old != me) || F.G != 256) atomicAdd((unsigned*)(F.ctl + 2), 1u);
    }
#define XCD_BAR() do { if (N_LAUNCHES == 1) xcd_barrier(bar, loc_ok); } while (0)
    const int lo = args.ph_lo, hi = args.ph_hi;
#ifdef ONLY_PHASE
#define IN(k) ((k) == ONLY_PHASE && lo <= (k) && (k) < hi)
#else
#define IN(k) (lo <= (k) && (k) < hi)
#endif
#define BOTH(k) (IN(k) && IN((k) + 1))
    unsigned char* ws = args.ws;
    bf16* XB = (bf16*)(ws + WS_XB); bf16* HB = (bf16*)(ws + WS_H); bf16* YG = (bf16*)(ws + WS_YG); bf16* YC = (bf16*)(ws + WS_YCAT);
    bf16* Z = (bf16*)(ws + WS_Z); float* ST = (float*)(ws + WS_STATS);
    const int bid = blockIdx.x;

    if (IN(0)) { p0a_phase(F, args, true, F.vcu * NWAVES + F.wave, F.G * NWAVES, 0, NITEMS_EARLY); if (BOTH(0)) GRID_BAR(); }
    if (N_LAUNCHES == 1) loc_ok = (xb_ld((unsigned*)(F.ctl + 2)) == 0u) && F.MISC[8] == 32u && F.MISC[9] == 8u;
    if (IN(1)) { p0b_phase(F, args); if (BOTH(1)) XCD_BAR(); }
    if (IN(2)) {
        pg8::Gemm g{XB, (const bf16*)(ws + WS_W_IN0), M, N0, D}; pg8::StaticOrder S; S.init(M, N0, F.G, bid);
        pg8::EpiBf16 E{HB, N0};
        pg8::gemm_phase<pg8::EpiBf16, pg8::StaticOrder, PG8_ALIGN, PG8_SP2>(F.lds + RING_OFF, g, S, E);
        if (BOTH(2)) XCD_BAR();
    }
    if (IN(3)) {
        if (bid < 64) chunk_mixer_unit<0>(F, args, bid & 7, bid >> 3);
        else if (bid < 192) { s5_wave_unit(F, args, bid & 7, ((bid - 64) >> 3) * 8 + F.wave, F.lds + RING_OFF + F.wave * 12800);
            __syncthreads();
            p0a_phase(F, args, false, (bid - 64) * NWAVES + F.wave, 128 * NWAVES, NITEMS_EARLY, NITEMS_P3B); }
        else p0a_phase(F, args, false, (bid - 192) * NWAVES + F.wave, (F.G - 192) * NWAVES, NITEMS_P3B, NITEMS_P7);
        if (BOTH(3)) GRID_BAR();
    }
    if (IN(4)) {
        pg8::Gemm g{YG, (const bf16*)(ws + WS_W_GLU), M, S5W, S5W}; pg8::StaticOrder S; S.init(M, S5W, F.G, bid);
        pg8::EpiGlu E{YG, S5W, YC, D};
        pg8::gemm_phase<pg8::EpiGlu, pg8::StaticOrder, PG8_ALIGN, PG8_SP2>(F.lds + RING_OFF, g, S, E);
        if (BOTH(4)) XCD_BAR();
    }
    if (IN(5)) {
        pg8::Gemm g{YC, (const bf16*)(ws + WS_W_OUT0), M, D, D}; pg8::StaticOrder S; S.init(M, D, F.G, bid);
        pg8::EpiResT<false> E{args.in[I_X], Z, D, DN_ALPHA, nullptr, nullptr, nullptr};
        pg8::gemm_phase<pg8::EpiResT<false>, pg8::StaticOrder, PG8_ALIGN, PG8_SP2>(F.lds + RING_OFF, g, S, E);
        if (BOTH(5)) XCD_BAR();
    }
    if (IN(6)) { ln_phase(F, Z, args.in[I_LN_MIX_G], args.in[I_LN_MIX_B], nullptr, XB, ST); if (BOTH(6)) XCD_BAR(); }
    if (IN(7)) {
        pg8::Gemm g{XB, (const bf16*)(ws + WS_W_GU0), M, NGU, D}; pg8::StaticOrder S; S.init(M, NGU, F.G, bid);
        pg8::EpiSwiGlu E{HB, FF, HSLAB_EL};
        pg8::gemm_phase<pg8::EpiSwiGlu, pg8::StaticOrder, PG8_ALIGN, PG8_SP2>(F.lds + RING_OFF, g, S, E);
        if (bid >= 128) p0a_phase(F, args, false, (bid - 128) * NWAVES + F.wave, (F.G - 128) * NWAVES, NITEMS_P7, NITEMS_P14);
        if (BOTH(7)) XCD_BAR();
    }
    if (IN(8)) {
        pg8::Gemm g{HB, (const bf16*)(ws + WS_W_DN0), M, D, FF, HSLAB_EL * 2}; pg8::StaticOrder S; S.init(M, D, F.G, bid);
        pg8::EpiResT<true> E{nullptr, Z, D, DN_ALPHA, ST, args.in[I_LN_MIX_G], args.in[I_LN_MIX_B]};
        pg8::gemm_phase<pg8::EpiResT<true>, pg8::StaticOrder, PG8_ALIGN, PG8_SP2>(F.lds + RING_OFF, g, S, E);
        if (BOTH(8)) XCD_BAR();
    }
    if (IN(9)) { ln_phase(F, Z, args.in[I_LN_FFN_G], args.in[I_LN_FFN_B], nullptr, XB, ST); if (BOTH(9)) XCD_BAR(); }
    if (IN(10)) {
        pg8::Gemm g{XB, (const bf16*)(ws + WS_W_IN1), M, OD_IN, D}; pg8::StaticOrder S; S.init(M, OD_IN, F.G, bid);
        pg8::EpiBf16 E{HB, OD_IN};
        pg8::gemm_phase<pg8::EpiBf16, pg8::StaticOrder, PG8_ALIGN, PG8_SP2>(F.lds + RING_OFF, g, S, E);
        if (BOTH(10)) XCD_BAR();
    }
    if (IN(11)) { for (int u = bid; u < 256; u += F.G) chunk_mixer_unit<1>(F, args, u & 7, u >> 3); if (BOTH(11)) XCD_BAR(); }
    if (IN(12)) {
        pg8::Gemm g{YC, (const bf16*)(ws + WS_W_OUT1), M, D, D}; pg8::StaticOrder S; S.init(M, D, F.G, bid);
        pg8::EpiResT<true> E{nullptr, Z, D, DN_ALPHA, ST, args.in[I_LN_FFN_G], args.in[I_LN_FFN_B]};
        pg8::gemm_phase<pg8::EpiResT<true>, pg8::StaticOrder, PG8_ALIGN, PG8_SP2>(F.lds + RING_OFF, g, S, E);
        if (BOTH(12)) XCD_BAR();
    }
    if (IN(13)) { ln_phase(F, Z, args.in[I_LN_MIX_G] + D, args.in[I_LN_MIX_B] + D, nullptr, XB, ST); if (BOTH(13)) GRID_BAR(); }
    if (IN(14)) {
        pg8::Gemm g{XB, (const bf16*)(ws + WS_W_GU1), M, NGU, D}; pg8::StaticOrder S; S.init(M, NGU, F.G, bid);
        pg8::EpiSwiGlu E{HB, FF, HSLAB_EL};
        pg8::gemm_phase<pg8::EpiSwiGlu, pg8::StaticOrder, PG8_ALIGN, PG8_SP2>(F.lds + RING_OFF, g, S, E);
        if (bid >= 128) p0a_phase(F, args, false, (bid - 128) * NWAVES + F.wave, (F.G - 128) * NWAVES, NITEMS_P14, NITEMS);
        if (BOTH(14)) GRID_BAR();
    }
    if (IN(15)) {
        pg8::Gemm g{HB, (const bf16*)(ws + WS_W_DN1), M, D, FF, HSLAB_EL * 2}; pg8::StaticOrder S; S.init(M, D, F.G, bid);
        pg8::EpiResT<true> E{nullptr, Z, D, DN_ALPHA, ST, args.in[I_LN_MIX_G] + D, args.in[I_LN_MIX_B] + D};
        pg8::gemm_phase<pg8::EpiResT<true>, pg8::StaticOrder, PG8_ALIGN, PG8_SP2>(F.lds + RING_OFF, g, S, E);
        if (BOTH(15)) XCD_BAR();
    }
    if (IN(16)) { ln_phase(F, Z, args.in[I_LN_FFN_G] + D, args.in[I_LN_FFN_B] + D, F.out, nullptr, nullptr); }
#undef IN
#undef BOTH
}

extern "C" void kernel_launch(void* const* d_in, const int* in_sizes, int n_in, void* d_out, int out_size, void* d_ws, size_t ws_size, hipStream_t stream) {
    static int grid = 0;
    if (grid == 0) {
        if (n_in != 26 || in_sizes[0] != M * D || out_size != M * D || ws_size < WS_END) { fprintf(stderr, "kernel_launch: unexpected problem: n_in %d in0 %d out %d ws %zu (need %zu)\n", n_in, n_in > 0 ? in_sizes[0] : -1, out_size, ws_size, (size_t)WS_END); grid = -1; return; }
        if (hipFuncSetAttribute((const void*)fwd_kernel, hipFuncAttributeMaxDynamicSharedMemorySize, LDS_BYTES) != hipSuccess) { fprintf(stderr, "kernel_launch: hipFuncSetAttribute failed\n"); grid = -1; return; }
        int per_cu = 0;
        if (hipOccupancyMaxActiveBlocksPerMultiprocessor(&per_cu, (const void*)fwd_kernel, NWAVES * 64, LDS_BYTES) != hipSuccess || per_cu < 1)
            fprintf(stderr, "kernel_launch: note: occupancy query reports %d workgroups per CU\n", per_cu);
        (void)hipGetLastError();
        grid = 256;
    }
    if (grid < 0) return;
    if (hipMemsetAsync((char*)d_ws + WS_CTL, 0, CTL_ZERO_BYTES, stream) != hipSuccess) { fprintf(stderr, "kernel_launch: memset failed\n"); return; }
    Args a{};
    for (int i = 0; i < 26; ++i) a.in[i] = (const float*)d_in[i];
    a.out = (float*)d_out; a.ws = (unsigned char*)d_ws;
#ifndef PROBE_REPS
#define PROBE_REPS {1,1,1,1,1,1,1,1,1,1,1,1,1,1,1,1,1}
#endif
    static const int probe_reps[NPH] = PROBE_REPS;
    for (int li = 0; li < N_LAUNCHES; ++li) for (int rep = 0; rep < (N_LAUNCHES == 1 ? 1 : probe_reps[li]); ++rep) {
        a.ph_lo = (N_LAUNCHES == 1) ? 0 : li; a.ph_hi = (N_LAUNCHES == 1) ? NPH : li + 1; a.li = li; a.pad = 0;
        hipLaunchKernelGGL(fwd_kernel, dim3(grid), dim3(NWAVES * 64), LDS_BYTES, stream, a);
        const hipError_t le = hipPeekAtLastError();
        if (le != hipSuccess) { fprintf(stderr, "kernel_launch: launch %d failed: %s\n", li, hipGetErrorName(le)); break; }
    }
}
```
